# Optimizing an MI355X kernel written in HIP

```python
import math
import jax, jax.numpy as jnp
from jax import lax
import numpy as np


D_MODEL = 1024
BATCH = 16
SEQ = 256
DEPTH = 2
DEC_BATCH = 4
DEC_SEQ = 2048
PAST_LEN = 512

GRID_W = 64
N_EVEN = (DEPTH + 1) // 2
N_ODD = DEPTH // 2
DA_HEADS = 4
DA_QK = 64
DA_V = 2 * DA_QK
DA_WIDTH = DA_HEADS * DA_V
S5_WIDTH = D_MODEL - DA_WIDTH
S5_CH = 16
S5_GROUPS = S5_WIDTH // S5_CH
S5_STATE = 64
IN_WIDTH = 3 * DA_WIDTH + S5_WIDTH
POOL_WINDOWS = (2, 4, 8, 16)
POOL_GROUPS = len(POOL_WINDOWS)
POOL_CH = D_MODEL // POOL_GROUPS
FF_HIDDEN = 4 * D_MODEL
N_MOD = 6
ROPE_BASE = 10000.0
Q_BLOCK = 128
EPS = 1e-6

kernel_name = 'hybrid_diffattn_s5_pool_diffusion_step'


def rmsnorm(x, g):
    xf = x.astype(jnp.float32)
    y = xf * lax.rsqrt(jnp.mean(xf * xf, axis=-1, keepdims=True) + EPS)
    return y.astype(x.dtype) * g


def modulate(h, shift, scale):
    return h * (1 + scale) + shift


def axial_angles(L):
    rows = L // GRID_W
    row = jnp.repeat(jnp.arange(rows), GRID_W).astype(jnp.float32)
    col = jnp.tile(jnp.arange(GRID_W), rows).astype(jnp.float32)
    half = DA_QK // 2
    inv = 1.0 / (ROPE_BASE ** (jnp.arange(0, half, 2, dtype=jnp.float32) / half))
    return row[:, None] * inv, col[:, None] * inv


def rotate(seg, ang):
    cos = jnp.cos(ang)[None, :, None, None, :].astype(seg.dtype)
    sin = jnp.sin(ang)[None, :, None, None, :].astype(seg.dtype)
    x1, x2 = jnp.split(seg, 2, axis=-1)
    return jnp.concatenate([x1 * cos - x2 * sin, x2 * cos + x1 * sin], axis=-1)


def axial_rope(x):
    ang_r, ang_c = axial_angles(x.shape[1])
    half = DA_QK // 2
    return jnp.concatenate([rotate(x[..., :half], ang_r), rotate(x[..., half:], ang_c)], axis=-1)


def split_in(h, w_in):
    B, L, _ = h.shape
    z = h @ w_in
    q = z[..., :DA_WIDTH].reshape(B, L, DA_HEADS, 2, DA_QK)
    k = z[..., DA_WIDTH:2 * DA_WIDTH].reshape(B, L, DA_HEADS, 2, DA_QK)
    v = z[..., 2 * DA_WIDTH:3 * DA_WIDTH].reshape(B, L, DA_HEADS, DA_V)
    u = z[..., 3 * DA_WIDTH:]
    return q, k, v, u


def diff_lambda(lambda_qk, lam_init):
    lq1, lk1, lq2, lk2 = lambda_qk.astype(jnp.float32)
    return jnp.exp(jnp.sum(lq1 * lk1)) - jnp.exp(jnp.sum(lq2 * lk2)) + lam_init


def diff_attention(q, k, v, lam):
    B, Lq = q.shape[0], q.shape[1]
    nblk = Lq // Q_BLOCK
    scale = DA_QK ** -0.5
    qb = q.reshape(B, nblk, Q_BLOCK, DA_HEADS, 2, DA_QK).transpose(1, 0, 2, 3, 4, 5)

    def one_block(qblk):
        s = jnp.einsum('bqhmd,bkhmd->bhmqk', qblk, k).astype(jnp.float32) * scale
        p = jax.nn.softmax(s, axis=-1)
        w = p[:, :, 0] - lam * p[:, :, 1]
        return jnp.einsum('bhqk,bkhe->bqhe', w.astype(v.dtype), v)

    out = lax.map(one_block, qb)
    return out.transpose(1, 0, 2, 3, 4).reshape(B, Lq, DA_HEADS, DA_V)


def diff_head_out(o, subln_g, lam_init):
    B, L = o.shape[0], o.shape[1]
    o = rmsnorm(o, subln_g) * (1.0 - lam_init)
    return o.reshape(B, L, DA_WIDTH)


def s5_discretize(lam_re, lam_im, log_dt, b_re, b_im):
    lam_re = lam_re.astype(jnp.float32)
    lam_im = lam_im.astype(jnp.float32)
    dt = jnp.exp(log_dt.astype(jnp.float32))[:, None]
    mag = jnp.exp(lam_re * dt)
    ang = lam_im * dt
    a_re = mag * jnp.cos(ang)
    a_im = mag * jnp.sin(ang)
    den = lam_re * lam_re + lam_im * lam_im
    f_re = ((a_re - 1.0) * lam_re + a_im * lam_im) / den
    f_im = (a_im * lam_re - (a_re - 1.0) * lam_im) / den
    b_re = b_re.astype(jnp.float32)
    b_im = b_im.astype(jnp.float32)
    bb_re = f_re[..., None] * b_re - f_im[..., None] * b_im
    bb_im = f_re[..., None] * b_im + f_im[..., None] * b_re
    return a_re, a_im, bb_re, bb_im


def complex_affine_combine(e1, e2):
    a1r, a1i, b1r, b1i = e1
    a2r, a2i, b2r, b2i = e2
    return (a2r * a1r - a2i * a1i,
            a2r * a1i + a2i * a1r,
            a2r * b1r - a2i * b1i + b2r,
            a2r * b1i + a2i * b1r + b2i)


def s5_direction(uf, lam_re, lam_im, log_dt, b_re, b_im, c_re, c_im, h0, reverse):
    a_re, a_im, bb_re, bb_im = s5_discretize(lam_re, lam_im, log_dt, b_re, b_im)
    bu_re = jnp.einsum('blgh,gph->blgp', uf, bb_re)
    bu_im = jnp.einsum('blgh,gph->blgp', uf, bb_im)
    if h0 is not None:
        h0_re, h0_im = h0
        pos = -1 if reverse else 0
        bu_re = bu_re.at[:, pos].add(a_re * h0_re - a_im * h0_im)
        bu_im = bu_im.at[:, pos].add(a_re * h0_im + a_im * h0_re)
    elems = (jnp.broadcast_to(a_re, bu_re.shape), jnp.broadcast_to(a_im, bu_re.shape), bu_re, bu_im)
    _, _, h_re, h_im = lax.associative_scan(complex_affine_combine, elems, reverse=reverse, axis=1)
    y = (jnp.einsum('blgp,ghp->blgh', h_re, c_re.astype(jnp.float32))
         - jnp.einsum('blgp,ghp->blgh', h_im, c_im.astype(jnp.float32)))
    last = 0 if reverse else -1
    return y, h_re[:, last], h_im[:, last]


def s5_mixer(u, lam_re, lam_im, log_dt, b_re, b_im, c_re, c_im, d_skip, w_glu, h0):
    B, L, _ = u.shape
    uf = u.astype(jnp.float32).reshape(B, L, S5_GROUPS, S5_CH)
    ys, finals = [], []
    for dr in (0, 1):
        init = None if h0 is None else (h0[:, dr, :, :, 0].astype(jnp.float32), h0[:, dr, :, :, 1].astype(jnp.float32))
        y, fr, fi = s5_direction(uf, lam_re[dr], lam_im[dr], log_dt[dr], b_re[dr], b_im[dr],
                                 c_re[dr], c_im[dr], init, dr == 1)
        ys.append(y)
        finals.append(jnp.stack([fr, fi], axis=-1))
    y = (ys[0] + ys[1]).reshape(B, L, S5_WIDTH) + d_skip.astype(jnp.float32) * u.astype(jnp.float32)
    g = jax.nn.gelu(y).astype(u.dtype)
    out = g * jax.nn.sigmoid(g @ w_glu)
    state = jnp.stack(finals, axis=1).astype(u.dtype) if h0 is None else None
    return out, state


def pool_mixer(h, pool_w, pool_scale):
    B, L, D = h.shape
    hf = h.astype(jnp.float32)
    csum = jnp.concatenate([jnp.zeros((B, 1, D), jnp.float32), jnp.cumsum(hf, axis=1)], axis=1)
    t = jnp.arange(L)
    outs = []
    for g, w in enumerate(POOL_WINDOWS):
        lo = jnp.clip(t - w // 2, 0, L)
        hi = jnp.clip(t + w // 2, 0, L)
        seg = csum[..., g * POOL_CH:(g + 1) * POOL_CH]
        mean = (seg[:, hi] - seg[:, lo]) / (hi - lo).astype(jnp.float32)[None, :, None]
        outs.append(mean - hf[..., g * POOL_CH:(g + 1) * POOL_CH])
    z = jnp.stack(outs, axis=2).astype(h.dtype)
    z = jnp.einsum('blgc,gcd->blgd', z, pool_w).reshape(B, L, D)
    return z * pool_scale


def sq_relu_mlp(h, w1, w2):
    return jnp.square(jax.nn.relu(h @ w1)) @ w2


def setup_inputs(seed: int = 0) -> dict:
    key = jax.random.key(seed)
    ks = jax.random.split(key, 32)
    nrm = jax.random.normal
    f32 = jnp.float32
    lam_im_base = jnp.pi * jnp.arange(S5_STATE, dtype=f32)
    return {
        'x_prompt': nrm(ks[0], (BATCH, SEQ, D_MODEL), f32),
        'x_sample': nrm(ks[1], (DEC_BATCH, DEC_SEQ, D_MODEL), f32),
        'cache_k': nrm(ks[2], (DEC_BATCH, N_EVEN, PAST_LEN, DA_HEADS, 2 * DA_QK), f32),
        'cache_v': nrm(ks[3], (DEC_BATCH, N_EVEN, PAST_LEN, DA_HEADS, DA_V), f32),
        'state_s5': 0.5 * nrm(ks[4], (DEC_BATCH, N_EVEN, 2, S5_GROUPS, S5_STATE, 2), f32),
        'c': nrm(ks[5], (DEC_BATCH, D_MODEL), f32),
        'c_ctx': nrm(ks[6], (D_MODEL,), f32),
        'mod_w': 0.5 * D_MODEL ** -0.5 * nrm(ks[7], (DEPTH, D_MODEL, N_MOD * D_MODEL), f32),
        'mod_b': 0.01 * nrm(ks[8], (DEPTH, N_MOD * D_MODEL), f32),
        'norm_g': 1.0 + 0.02 * nrm(ks[9], (DEPTH, 2, D_MODEL), f32),
        'mix_w_in': D_MODEL ** -0.5 * nrm(ks[10], (N_EVEN, D_MODEL, IN_WIDTH), f32),
        'mix_w_out': D_MODEL ** -0.5 * nrm(ks[11], (N_EVEN, D_MODEL, D_MODEL), f32),
        'diff_lambda_qk': 0.1 * nrm(ks[12], (N_EVEN, 4, DA_QK), f32),
        'diff_subln_g': 1.0 + 0.02 * nrm(ks[13], (N_EVEN, DA_V), f32),
        's5_lambda_re': -0.5 + 0.01 * nrm(ks[14], (N_EVEN, 2, S5_GROUPS, S5_STATE), f32),
        's5_lambda_im': lam_im_base + 0.01 * nrm(ks[15], (N_EVEN, 2, S5_GROUPS, S5_STATE), f32),
        's5_log_dt': jax.random.uniform(ks[16], (N_EVEN, 2, S5_GROUPS), f32, math.log(1e-3), math.log(1e-1)),
        's5_b_re': (2 * S5_CH) ** -0.5 * nrm(ks[17], (N_EVEN, 2, S5_GROUPS, S5_STATE, S5_CH), f32),
        's5_b_im': (2 * S5_CH) ** -0.5 * nrm(ks[18], (N_EVEN, 2, S5_GROUPS, S5_STATE, S5_CH), f32),
        's5_c_re': (2 * S5_STATE) ** -0.5 * nrm(ks[19], (N_EVEN, 2, S5_GROUPS, S5_CH, S5_STATE), f32),
        's5_c_im': (2 * S5_STATE) ** -0.5 * nrm(ks[20], (N_EVEN, 2, S5_GROUPS, S5_CH, S5_STATE), f32),
        's5_d': nrm(ks[21], (N_EVEN, S5_WIDTH), f32),
        's5_w_glu': S5_WIDTH ** -0.5 * nrm(ks[22], (N_EVEN, S5_WIDTH, S5_WIDTH), f32),
        'pool_w': POOL_CH ** -0.5 * nrm(ks[23], (N_ODD, POOL_GROUPS, POOL_CH, POOL_CH), f32),
        'pool_scale': 1.0 + 0.02 * nrm(ks[24], (N_ODD, D_MODEL), f32),
        'ff_w1': D_MODEL ** -0.5 * nrm(ks[25], (DEPTH, D_MODEL, FF_HIDDEN), f32),
        'ff_w2': FF_HIDDEN ** -0.5 * nrm(ks[26], (DEPTH, FF_HIDDEN, D_MODEL), f32),
        'final_norm_g': 1.0 + 0.02 * nrm(ks[27], (D_MODEL,), f32),
    }


def reference(x_prompt, x_sample, cache_k, cache_v, state_s5, c, c_ctx, mod_w, mod_b, norm_g,
              mix_w_in, mix_w_out, diff_lambda_qk, diff_subln_g, s5_lambda_re, s5_lambda_im, s5_log_dt,
              s5_b_re, s5_b_im, s5_c_re, s5_c_im, s5_d, s5_w_glu, pool_w, pool_scale, ff_w1, ff_w2,
              final_norm_g):
    ctx = x_prompt
    lat = x_sample
    new_k, new_v, new_s = [], [], []
    for i in range(DEPTH):
        m_ctx = (jax.nn.silu(c_ctx) @ mod_w[i] + mod_b[i]).reshape(N_MOD, D_MODEL)
        m_lat = (jax.nn.silu(c) @ mod_w[i] + mod_b[i]).reshape(-1, N_MOD, 1, D_MODEL)
        hc = modulate(rmsnorm(ctx, norm_g[i, 0]), m_ctx[0], m_ctx[1])
        hl = modulate(rmsnorm(lat, norm_g[i, 0]), m_lat[:, 0], m_lat[:, 1])
        if i % 2 == 0:
            j = i // 2
            lam_init = 0.8 - 0.6 * math.exp(-0.3 * i)
            lam = diff_lambda(diff_lambda_qk[j], lam_init)
            s5p = (s5_lambda_re[j], s5_lambda_im[j], s5_log_dt[j], s5_b_re[j], s5_b_im[j],
                   s5_c_re[j], s5_c_im[j], s5_d[j], s5_w_glu[j])
            qc, kc, vc, uc = split_in(hc, mix_w_in[j])
            ac = diff_attention(qc, kc, vc, lam)
            sc, st_c = s5_mixer(uc, *s5p, None)
            oc = jnp.concatenate([diff_head_out(ac, diff_subln_g[j], lam_init), sc], axis=-1) @ mix_w_out[j]
            new_k.append(kc.reshape(kc.shape[0], kc.shape[1], DA_HEADS, 2 * DA_QK))
            new_v.append(vc)
            new_s.append(st_c)
            ql, kl, vl, ul = split_in(hl, mix_w_in[j])
            ql, kl = axial_rope(ql), axial_rope(kl)
            ck = cache_k[:, j].reshape(cache_k.shape[0], cache_k.shape[2], DA_HEADS, 2, DA_QK)
            k_all = jnp.concatenate([kl, ck], axis=1)
            v_all = jnp.concatenate([vl, cache_v[:, j]], axis=1)
            al = diff_attention(ql, k_all, v_all, lam)
            sl, _ = s5_mixer(ul, *s5p, state_s5[:, j])
            ol = jnp.concatenate([diff_head_out(al, diff_subln_g[j], lam_init), sl], axis=-1) @ mix_w_out[j]
        else:
            j = i // 2
            oc = pool_mixer(hc, pool_w[j], pool_scale[j])
            ol = pool_mixer(hl, pool_w[j], pool_scale[j])
        ctx = ctx + m_ctx[2] * oc
        lat = lat + m_lat[:, 2] * ol
        hc = modulate(rmsnorm(ctx, norm_g[i, 1]), m_ctx[3], m_ctx[4])
        hl = modulate(rmsnorm(lat, norm_g[i, 1]), m_lat[:, 3], m_lat[:, 4])
        ctx = ctx + m_ctx[5] * sq_relu_mlp(hc, ff_w1[i], ff_w2[i])
        lat = lat + m_lat[:, 5] * sq_relu_mlp(hl, ff_w1[i], ff_w2[i])
    y_prompt = rmsnorm(ctx, final_norm_g)
    y_sample = rmsnorm(lat, final_norm_g)
    new_cache_k = jnp.stack(new_k, axis=1)
    new_cache_v = jnp.stack(new_v, axis=1)
    new_state_s5 = jnp.stack(new_s, axis=1)
    return (y_prompt, y_sample, new_cache_k, new_cache_v, new_state_s5)
```

```cpp
#include <hip/hip_runtime.h>
#include <hip/hip_cooperative_groups.h>
#include <cstdio>
namespace cg = cooperative_groups;

#define DI __device__ __forceinline__
typedef unsigned short bf16_t;
using bf16x8 = __attribute__((ext_vector_type(8))) short;
using f32x4  = __attribute__((ext_vector_type(4))) float;
using f32x16 = __attribute__((ext_vector_type(16))) float;
using u32x4  = __attribute__((ext_vector_type(4))) unsigned;
using u32x2  = __attribute__((ext_vector_type(2))) unsigned;
typedef __bf16 bf2_t __attribute__((ext_vector_type(2)));
typedef float fl2_t __attribute__((ext_vector_type(2)));

constexpr int NTHREADS = 512;
constexpr int T_ALL = 12288;
constexpr int LDS_ST_OFF = 139264;
constexpr int LDS_STATS_OFF = LDS_ST_OFF + 64;
constexpr int SHM_BYTES = LDS_STATS_OFF + 4096;

constexpr size_t OFF_MODP = 0;
constexpr size_t SZ_MODP  = 32ull * 2 * 5 * 6144 * 4;
constexpr size_t OFF_MODF = OFF_MODP + SZ_MODP;
constexpr size_t SZ_MODF  = 2ull * 5 * 6 * 1024 * 4;
constexpr size_t OFF_WIN  = OFF_MODF + SZ_MODF;
constexpr size_t SZ_WIN   = 2048ull * 1024 * 2;
constexpr size_t OFF_WOUT = OFF_WIN + SZ_WIN;
constexpr size_t SZ_WOUT  = 1024ull * 1024 * 2;
constexpr size_t OFF_WGLU = OFF_WOUT + SZ_WOUT;
constexpr size_t SZ_WGLU  = 512ull * 512 * 2;
constexpr size_t OFF_WPOOL = OFF_WGLU + SZ_WGLU;
constexpr size_t SZ_WPOOL = 4ull * 256 * 256 * 2;
constexpr size_t OFF_W1   = OFF_WPOOL + SZ_WPOOL;
constexpr size_t SZ_W1    = 2ull * 4096 * 1024 * 2;
constexpr size_t OFF_W2   = OFF_W1 + SZ_W1;
constexpr size_t SZ_W2    = 2ull * 1024 * 4096 * 2;
constexpr size_t OFF_HN   = OFF_W2 + SZ_W2;
constexpr size_t SZ_HN    = 12288ull * 1024 * 2;
constexpr size_t OFF_X    = OFF_HN + SZ_HN;
constexpr size_t SZ_X     = 12288ull * 1024 * 4;
constexpr size_t OFF_RSTD = OFF_X + SZ_X;
constexpr size_t SZ_RSTD  = 12288ull * 4;
constexpr size_t OFF_S5TA = OFF_RSTD + SZ_RSTD;
constexpr size_t SZ_S5TA  = 2ull * 32 * 64 * 16;
constexpr size_t OFF_S5TB = OFF_S5TA + SZ_S5TA;
constexpr size_t SZ_S5TB  = 2ull * 32 * 8 * 64 * 16;
constexpr size_t OFF_S5TC = OFF_S5TB + SZ_S5TB;
constexpr size_t SZ_S5TC  = 2ull * 32 * 4 * 64 * 16;
constexpr size_t OFF_BAR  = OFF_S5TC + SZ_S5TC;
constexpr size_t SZ_BAR   = 16384;
constexpr size_t OFF_R    = OFF_BAR + SZ_BAR;
constexpr size_t OFF_Q    = OFF_R;
constexpr size_t SZ_Q     = 12288ull * 512 * 2;
constexpr size_t OFF_K    = OFF_Q + SZ_Q;
constexpr size_t SZ_K     = 14336ull * 512 * 2;
constexpr size_t OFF_V    = OFF_K + SZ_K;
constexpr size_t SZ_V     = SZ_K;
constexpr size_t OFF_U    = OFF_V + SZ_V;
constexpr size_t SZ_U     = 12288ull * 512 * 4;
constexpr size_t OFF_E    = OFF_U + SZ_U;
constexpr size_t SZ_E     = 192ull * 32 * 2 * 64 * 2 * 4;
constexpr size_t OFF_GS5  = OFF_E + SZ_E;
constexpr size_t SZ_GS5   = 12288ull * 512 * 2;
constexpr size_t OFF_CAT  = OFF_GS5 + SZ_GS5;
constexpr size_t SZ_CAT   = 12288ull * 1024 * 2;
constexpr size_t END_MIX  = OFF_CAT + SZ_CAT;
constexpr size_t OFF_H    = OFF_R;
constexpr size_t SZ_H     = 12288ull * 4096 * 2;
constexpr size_t END_H    = OFF_H + SZ_H;
constexpr size_t WS_NEEDED = END_MIX > END_H ? END_MIX : END_H;

constexpr size_t OUT_Y  = 0;
constexpr size_t OUT_K  = 12288ull * 1024;
constexpr size_t OUT_V  = OUT_K + 4096ull * 512;
constexpr size_t OUT_S  = OUT_V + 4096ull * 512;

struct Params {
  const float *x_prompt, *x_sample, *cache_k, *cache_v, *state_s5, *c, *c_ctx, *mod_w, *mod_b, *norm_g,
      *w_in, *w_out, *dl_qk, *subln_g, *lam_re, *lam_im, *log_dt, *b_re, *b_im, *c_re, *c_im, *s5_d, *w_glu,
      *pool_w, *pool_scale, *ff_w1, *ff_w2, *final_g;
  float* out;
  char* ws;
  int phase_lo, phase_hi;
  int rep_phase, pad0;
};

typedef const Params __attribute__((address_space(4)))* PP;
extern __shared__ __attribute__((aligned(16))) char g_smem[];
DI PP get_pp() { PP kp = (PP)__builtin_amdgcn_kernarg_segment_ptr(); asm volatile("" : "+s"(kp)); return kp; }

DI unsigned pk2(float a, float b) {
  fl2_t f = {a, b};
  bf2_t r = __builtin_convertvector(f, bf2_t);
  return __builtin_bit_cast(unsigned, r);
}
DI bf16_t f2bf(float a) { return (bf16_t)(pk2(a, 0.f) & 0xffffu); }
DI float bf2f(bf16_t v) { return __uint_as_float(((unsigned)v) << 16); }
DI void wave_lds_sync() { asm volatile("s_waitcnt lgkmcnt(0)" ::: "memory"); __builtin_amdgcn_wave_barrier(); }
DI float wave_sum(float v) {
  v += __shfl_xor(v, 32); v += __shfl_xor(v, 16); v += __shfl_xor(v, 8);
  v += __shfl_xor(v, 4);  v += __shfl_xor(v, 2);  v += __shfl_xor(v, 1);
  return v;
}
DI int opaque_tid() { int t = threadIdx.x; asm volatile("" : "+v"(t)); return t; }
DI int mod_row(int tok) { return tok < 4096 ? 0 : 1 + ((tok - 4096) >> 11); }
DI int kv_row(int tok) {
  if (tok < 4096) return tok;
  int b = (tok - 4096) >> 11, l = (tok - 4096) & 2047;
  return 4096 + b * 2560 + l;
}
DI size_t vf_off(int base_rows, int nkt, int h, int kt, int dt, int s, int lane) {
  return (size_t)base_rows * 512 + ((((size_t)(h * nkt + kt) * 4 + dt) * 2 + s) * 64 + lane) * 8;
}

DI size_t kf_off(int base_rows, int nkt, int h, int m, int kt, int s, int lane) {
  return (size_t)base_rows * 512 + ((((size_t)((h * 2 + m) * nkt + kt)) * 4 + s) * 64 + lane) * 8;
}

DI void phase_mod_partial(PP p) {
  const int tid = opaque_tid();
  float* s_silu = (float*)g_smem;
  float* modp = (float*)(p->ws + OFF_MODP);
  const int nitems = 2 * 12 * 32;
  for (int it = blockIdx.x; it < nitems; it += gridDim.x) {
    int ks = it & 31, cc = (it >> 5) % 12, l = it / (32 * 12);
    __syncthreads();
    if (tid < 160) {
      int r = tid >> 5, k = tid & 31, kk = ks * 32 + k;
      float v = r == 0 ? p->c_ctx[kk] : p->c[(r - 1) * 1024 + kk];
      s_silu[tid] = v / (1.f + expf(-v));
    }
    __syncthreads();
    int n = cc * 512 + tid;
    const float* w = p->mod_w + ((size_t)l * 1024 + ks * 32) * 6144 + n;
    float a0 = 0, a1 = 0, a2 = 0, a3 = 0, a4 = 0;
#pragma unroll 8
    for (int k = 0; k < 32; ++k) {
      float wv = w[(size_t)k * 6144];
      a0 += s_silu[k] * wv; a1 += s_silu[32 + k] * wv; a2 += s_silu[64 + k] * wv;
      a3 += s_silu[96 + k] * wv; a4 += s_silu[128 + k] * wv;
    }
    float* o = modp + ((size_t)(ks * 2 + l) * 5) * 6144 + n;
    o[0] = a0; o[6144] = a1; o[2 * 6144] = a2; o[3 * 6144] = a3; o[4 * 6144] = a4;
  }
}

DI void transpose_tile4(const float* __restrict__ src, int K, int N, bf16_t* __restrict__ dst, int tk, int tn4, int tid) {
  float* tile = (float*)g_smem;
  float4 v[8];
#pragma unroll
  for (int i = 0; i < 8; ++i) {
    int idx = tid + 512 * i, r = idx >> 6, c4 = (idx & 63) * 4;
    v[i] = *(const float4*)(src + (size_t)(tk * 64 + r) * N + tn4 * 256 + c4);
  }
  __syncthreads();
#pragma unroll
  for (int i = 0; i < 8; ++i) {
    int idx = tid + 512 * i, r = idx >> 6, c4 = (idx & 63) * 4;
    float* t = tile + (c4 >> 6) * (64 * 65) + r * 65 + (c4 & 63);
    t[0] = v[i].x; t[1] = v[i].y; t[2] = v[i].z; t[3] = v[i].w;
  }
  __syncthreads();
#pragma unroll
  for (int q = 0; q < 4; ++q) {
    int n = tid >> 3, kc = tid & 7;
    const float* t = tile + q * (64 * 65);
    u32x4 o;
    for (int j = 0; j < 4; ++j)
      o[j] = pk2(t[(kc * 8 + 2 * j) * 65 + n], t[(kc * 8 + 2 * j + 1) * 65 + n]);
    *(u32x4*)(dst + (size_t)(tn4 * 256 + q * 64 + n) * K + tk * 64 + kc * 8) = o;
  }
}

DI void cmul(float ar, float ai, float br, float bi, float& cr, float& ci) { cr = ar * br - ai * bi; ci = ar * bi + ai * br; }
DI void s5_disc(PP p, int dr, int g, int pp, float& a_re, float& a_im, float& f_re, float& f_im) {
  const int idx = (dr * 32 + g) * 64 + pp;
  const float lr = p->lam_re[idx], li = p->lam_im[idx];
  const float dt = expf(p->log_dt[dr * 32 + g]);
  const float mag = expf(lr * dt), ang = li * dt;
  a_re = mag * cosf(ang); a_im = mag * sinf(ang);
  const float den = lr * lr + li * li;
  f_re = ((a_re - 1.f) * lr + a_im * li) / den;
  f_im = (a_im * lr - (a_re - 1.f) * li) / den;
}

DI void s5_build_tables(PP p, int dr, int g, int lane) {
  const int fr = lane & 15, fq = lane >> 4;
  float a_re, a_im, f_re, f_im;
  s5_disc(p, dr, g, lane, a_re, a_im, f_re, f_im);
  float A64r = a_re, A64i = a_im;
#pragma unroll
  for (int i = 0; i < 6; ++i) { float tr, ti; cmul(A64r, A64i, A64r, A64i, tr, ti); A64r = tr; A64i = ti; }
  ((float4*)(p->ws + OFF_S5TA))[(dr * 32 + g) * 64 + lane] = float4{a_re, a_im, A64r, A64i};
  u32x4* tb = (u32x4*)(p->ws + OFF_S5TB) + (size_t)((dr * 32 + g) * 8) * 64 + lane;
#pragma unroll
  for (int nt = 0; nt < 4; ++nt) {
    float are, aim, fre, fim;
    const int pp = 16 * nt + fr;
    s5_disc(p, dr, g, pp, are, aim, fre, fim);
    u32x4 ore = {0, 0, 0, 0}, oim = {0, 0, 0, 0};
    if (fq < 2) {
      const size_t bo = ((size_t)((dr * 32 + g) * 64 + pp)) * 16 + 8 * fq;
      float br[8], bi[8];
      *(float4*)&br[0] = *(const float4*)(p->b_re + bo); *(float4*)&br[4] = *(const float4*)(p->b_re + bo + 4);
      *(float4*)&bi[0] = *(const float4*)(p->b_im + bo); *(float4*)&bi[4] = *(const float4*)(p->b_im + bo + 4);
#pragma unroll
      for (int j = 0; j < 4; ++j) {
        float r0 = fre * br[2 * j] - fim * bi[2 * j], r1 = fre * br[2 * j + 1] - fim * bi[2 * j + 1];
        float i0 = fre * bi[2 * j] + fim * br[2 * j], i1 = fre * bi[2 * j + 1] + fim * br[2 * j + 1];
        ore[j] = pk2(r0, r1); oim[j] = pk2(i0, i1);
      }
    }
    tb[nt * 64] = ore; tb[(4 + nt) * 64] = oim;
  }
  u32x4* tc = (u32x4*)(p->ws + OFF_S5TC) + (size_t)((dr * 32 + g) * 4) * 64 + lane;
#pragma unroll
  for (int ks = 0; ks < 4; ++ks) {
    const int k0 = 32 * ks + 8 * fq;
    const float* src = (k0 < 64 ? p->c_re : p->c_im) + ((size_t)((dr * 32 + g) * 16 + fr)) * 64 + (k0 & 63);
    const float sg = k0 < 64 ? 1.f : -1.f;
    float4 v0 = *(const float4*)src, v1 = *(const float4*)(src + 4);
    tc[ks * 64] = u32x4{pk2(sg * v0.x, sg * v0.y), pk2(sg * v0.z, sg * v0.w), pk2(sg * v1.x, sg * v1.y), pk2(sg * v1.z, sg * v1.w)};
  }
}

DI void transpose_item(PP p, int tix, int tid) {
  const float* src; bf16_t* dst; int K, N, local;
  if (tix < 128) { src = p->w_in; K = 1024; N = 2048; dst = (bf16_t*)(p->ws + OFF_WIN); local = tix; }
  else if (tix < 192) { src = p->w_out; K = 1024; N = 1024; dst = (bf16_t*)(p->ws + OFF_WOUT); local = tix - 128; }
  else if (tix < 208) { src = p->w_glu; K = 512; N = 512; dst = (bf16_t*)(p->ws + OFF_WGLU); local = tix - 192; }
  else if (tix < 224) { int g = (tix - 208) >> 2; src = p->pool_w + (size_t)g * 65536; K = 256; N = 256;
                        dst = (bf16_t*)(p->ws + OFF_WPOOL) + (size_t)g * 65536; local = (tix - 208) & 3; }
  else if (tix < 736) { int l = (tix - 224) >> 8; src = p->ff_w1 + (size_t)l * 4194304; K = 1024; N = 4096;
                        dst = (bf16_t*)(p->ws + OFF_W1) + (size_t)l * 4194304; local = (tix - 224) & 255; }
  else { int l = (tix - 736) >> 8; src = p->ff_w2 + (size_t)l * 4194304; K = 4096; N = 1024;
         dst = (bf16_t*)(p->ws + OFF_W2) + (size_t)l * 4194304; local = (tix - 736) & 255; }
  int tpr = N >> 8;
  transpose_tile4(src, K, N, dst, local / tpr, local % tpr, tid);
}

DI void phase_prep(PP p, int part, int bid, int nb) {
  const int tid = opaque_tid();
  const float* modp = (const float*)(p->ws + OFF_MODP);
  float* modf = (float*)(p->ws + OFF_MODF);
  const int N_FIN = 120, N_TR = 224, N_CK = 256, N_CV = 256, N_S5 = 8;
  const int nitems = N_FIN + N_TR + N_CK + N_CV + N_S5;
  const int it_lo = part == 0 ? 0 : N_FIN + N_TR, it_hi = part == 0 ? N_FIN + N_TR : nitems;
  for (int it = it_lo + bid; it < it_hi; it += nb) {
    if (it < N_FIN) {
      const int idx = it * 512 + tid;
      const int l = idx / 30720, rem = idx - l * 30720, r = rem / 6144, c = rem - r * 6144, j = c >> 10, n = c & 1023;
      float part[32];
#pragma unroll
      for (int ks = 0; ks < 32; ++ks) part[ks] = modp[((size_t)(ks * 2 + l) * 5 + r) * 6144 + c];
      float sum = p->mod_b[l * 6144 + c];
#pragma unroll
      for (int ks = 0; ks < 32; ++ks) sum += part[ks];
      float* o = modf + (size_t)((l * 5 + r) * 6) * 1024 + n;
      if (j == 0) o[1024] = sum;
      else if (j == 1) o[0] = p->norm_g[(l * 2 + 0) * 1024 + n] * (1.f + sum);
      else if (j == 2) o[2 * 1024] = sum;
      else if (j == 3) o[4 * 1024] = sum;
      else if (j == 4) o[3 * 1024] = p->norm_g[(l * 2 + 1) * 1024 + n] * (1.f + sum);
      else o[5 * 1024] = sum;
    } else if (it < N_FIN + N_TR) {
      transpose_item(p, it - N_FIN, tid);
    } else if (it < N_FIN + N_TR + N_CK) {
      int idx = (it - N_FIN - N_TR) * 512 + tid;
      int lane = idx & 63, s = (idx >> 6) & 3, kt16 = (idx >> 8) & 15, mm = (idx >> 12) & 1, h = (idx >> 13) & 3, b = idx >> 15;
      int key = 32 * kt16 + (lane & 31), hh = lane >> 5;
      const float* src = p->cache_k + ((size_t)(b * 512 + key) * 4 + h) * 128 + mm * 64 + 16 * s + 8 * hh;
      float4 v0 = *(const float4*)src, v1 = *(const float4*)(src + 4);
      u32x4 o = {pk2(v0.x, v0.y), pk2(v0.z, v0.w), pk2(v1.x, v1.y), pk2(v1.z, v1.w)};
      bf16_t* Kb = (bf16_t*)(p->ws + OFF_K);
      *(u32x4*)(Kb + kf_off(4096 + b * 2560, 80, h, mm, 64 + kt16, s, lane)) = o;
    } else if (it >= N_FIN + N_TR + N_CK + N_CV) {
      const int w = (it - (N_FIN + N_TR + N_CK + N_CV)) * 8 + (tid >> 6);
      s5_build_tables(p, w >> 5, w & 31, tid & 63);
    } else {
      int idx = (it - N_FIN - N_TR - N_CK) * 512 + tid;
      int lane = idx & 63, s = (idx >> 6) & 1, dt = (idx >> 7) & 3, kt16 = (idx >> 9) & 15, h = (idx >> 13) & 3, b = idx >> 15;
      int hh = lane >> 5, dd = 32 * dt + (lane & 31);
      float v[8];
#pragma unroll
      for (int j = 0; j < 8; ++j) {
        int kk = 16 * s + 8 * (j >> 2) + 4 * hh + (j & 3);
        int key = 32 * kt16 + kk;
        v[j] = p->cache_v[((size_t)(b * 512 + key) * 4 + h) * 128 + dd];
      }
      u32x4 o = {pk2(v[0], v[1]), pk2(v[2], v[3]), pk2(v[4], v[5]), pk2(v[6], v[7])};
      bf16_t* Vf = (bf16_t*)(p->ws + OFF_V);
      *(u32x4*)(Vf + vf_off(4096 + b * 2560, 80, h, 64 + kt16, dt, s, lane)) = o;
    }
  }
}

DI void phase_norm(PP p, const float* xa, const float* xb, int layer, int jalpha, int mode, int rbeg = 0, int rend = T_ALL, int widx = -1, int nwv = 0) {
  const int tid = opaque_tid();
  const int lane = tid & 63, wid = tid >> 6;
  const int nW = widx < 0 ? gridDim.x * 8 : nwv, gw = widx < 0 ? (int)blockIdx.x * 8 + wid : rbeg + widx;
  const int T_END = rend;
  const float* modf = (const float*)(p->ws + OFF_MODF);
  bf16_t* hn = (bf16_t*)(p->ws + OFF_HN);
  float* rstd_buf = (float*)(p->ws + OFF_RSTD);
  constexpr int R = 3;
  for (int row0 = gw; row0 < T_END; row0 += nW * R) {
    float4 v[R][4];
    float ss[R];
#pragma unroll
    for (int r = 0; r < R; ++r) {
      const int row = row0 + r * nW;
      ss[r] = 0.f;
      if (row < T_END) {
        const float* x = row < 4096 ? xa + (size_t)row * 1024 : xb + (size_t)(row - 4096) * 1024;
#pragma unroll
        for (int i = 0; i < 4; ++i) v[r][i] = *(const float4*)(x + i * 256 + lane * 4);
      } else {
#pragma unroll
        for (int i = 0; i < 4; ++i) v[r][i] = float4{0.f, 0.f, 0.f, 0.f};
      }
    }
#pragma unroll
    for (int r = 0; r < R; ++r) {
#pragma unroll
      for (int i = 0; i < 4; ++i)
        ss[r] += v[r][i].x * v[r][i].x + v[r][i].y * v[r][i].y + v[r][i].z * v[r][i].z + v[r][i].w * v[r][i].w;
      ss[r] = wave_sum(ss[r]);
    }
#pragma unroll
    for (int r = 0; r < R; ++r) {
      const int row = row0 + r * nW;
      if (row >= T_END) continue;
      const float rstd = rsqrtf(ss[r] * (1.f / 1024.f) + 1e-6f);
      if (mode == 1) { if (lane == 0) rstd_buf[row] = rstd; continue; }
      if (mode == 2) {
#pragma unroll
        for (int i = 0; i < 4; ++i) {
          float4 g = *(const float4*)(p->final_g + i * 256 + lane * 4);
          float4 o = {v[r][i].x * rstd * g.x, v[r][i].y * rstd * g.y, v[r][i].z * rstd * g.z, v[r][i].w * rstd * g.w};
          *(float4*)(p->out + OUT_Y + (size_t)row * 1024 + i * 256 + lane * 4) = o;
        }
        continue;
      }
      const float* al = modf + (size_t)((layer * 5 + mod_row(row)) * 6 + jalpha) * 1024;
      const float* be = al + 1024;
#pragma unroll
      for (int i = 0; i < 4; ++i) {
        float4 a = *(const float4*)(al + i * 256 + lane * 4);
        float4 b = *(const float4*)(be + i * 256 + lane * 4);
        u32x2 o = {pk2(v[r][i].x * rstd * a.x + b.x, v[r][i].y * rstd * a.y + b.y),
                   pk2(v[r][i].z * rstd * a.z + b.z, v[r][i].w * rstd * a.w + b.w)};
        *(u32x2*)(hn + (size_t)row * 1024 + i * 256 + lane * 4) = o;
      }
    }
  }
}

constexpr int PNT = 8;
template <int HW>
DI void pool_windows(const float* __restrict__ X, const float* __restrict__ rstd, int base, int l, int L, int c, float4 (&sout)[PNT]) {
  constexpr int NR = 2 * HW + PNT - 1;
  float4 v[NR];
#pragma unroll
  for (int i = 0; i < NR; ++i) {
    const int q = l - HW + i;
    const bool ok = q >= 0 && q < L;
    const int qq = ok ? q : l;
    const float r = ok ? rstd[base + qq] : 0.f;
    const float4 x = *(const float4*)(X + (size_t)(base + qq) * 1024 + c);
    v[i] = float4{x.x * r, x.y * r, x.z * r, x.w * r};
  }
  float4 s = {0.f, 0.f, 0.f, 0.f};
#pragma unroll
  for (int i = 0; i < 2 * HW; ++i) { s.x += v[i].x; s.y += v[i].y; s.z += v[i].z; s.w += v[i].w; }
  sout[0] = s;
#pragma unroll
  for (int k = 1; k < PNT; ++k) {
    s.x += v[k - 1 + 2 * HW].x - v[k - 1].x; s.y += v[k - 1 + 2 * HW].y - v[k - 1].y;
    s.z += v[k - 1 + 2 * HW].z - v[k - 1].z; s.w += v[k - 1 + 2 * HW].w - v[k - 1].w;
    sout[k] = s;
  }
}
DI void phase_pool_z(PP p) {
  const int tid = opaque_tid();
  const float* X = (const float*)(p->ws + OFF_X);
  const float* rstd = (const float*)(p->ws + OFF_RSTD);
  const float* modf = (const float*)(p->ws + OFF_MODF);
  bf16_t* Z = (bf16_t*)(p->ws + OFF_HN);
  const int total = (T_ALL / PNT) * 256;
  for (int idx = blockIdx.x * NTHREADS + tid; idx < total; idx += gridDim.x * NTHREADS) {
    const int tok = (idx >> 8) * PNT, c = (idx & 255) * 4;
    const int grp = c >> 8, hw = 1 << grp;
    int base, l, L;
    if (tok < 4096) { base = tok & ~255; l = tok & 255; L = 256; }
    else { int t2 = tok - 4096; base = 4096 + (t2 & ~2047); l = t2 & 2047; L = 2048; }
    float4 sw[PNT];
    if (grp == 0) pool_windows<1>(X, rstd, base, l, L, c, sw);
    else if (grp == 1) pool_windows<2>(X, rstd, base, l, L, c, sw);
    else if (grp == 2) pool_windows<4>(X, rstd, base, l, L, c, sw);
    else pool_windows<8>(X, rstd, base, l, L, c, sw);
    const float4 a = *(const float4*)(modf + (size_t)((1 * 5 + mod_row(tok)) * 6 + 0) * 1024 + c);
#pragma unroll
    for (int k = 0; k < PNT; ++k) {
      const int lk = l + k;
      const int lo = max(lk - hw, 0), hi = min(lk + hw, L);
      const float inv = 1.f / (float)(hi - lo);
      const float r0 = rstd[tok + k];
      const float4 v0 = *(const float4*)(X + (size_t)(tok + k) * 1024 + c);
      const float4 s = sw[k];
      u32x2 o = {pk2(a.x * (s.x * inv - v0.x * r0), a.y * (s.y * inv - v0.y * r0)),
                 pk2(a.z * (s.z * inv - v0.z * r0), a.w * (s.w * inv - v0.w * r0))};
      *(u32x2*)(Z + (size_t)(tok + k) * 1024 + c) = o;
    }
  }
}

#define LAS __attribute__((address_space(3)))
constexpr int BM = 256, BK = 64, HALF = 128, HTB = HALF * BK * 2, NXCD = 8, WGM = 8;
DI int lds_byte(int r, int c) {
  const int st = (r >> 4) * 2 + (c >> 5), rr = r & 15, cc = c & 31, ob = rr * 64 + cc * 2;
  return st * 1024 + (ob ^ (((ob >> 9) & 1) << 5));
}
DI void stage_rc(int b, int& R, int& C) {
  const int st = b / 1024, sb = b % 1024, swz = sb ^ (((sb >> 9) & 1) << 5);
  R = (st >> 1) * 16 + swz / 64; C = (st & 1) * 32 + (swz % 64) / 2;
}
struct Unit { int pm, pn; };
DI bool unit_next(int i, int nM, int nN, int G, int c, Unit& u) {
  const int nwg = nM * nN;
  const long L = (long)i * G + c; if (L >= nwg) return false;
  int wgid = (int)L;
  { const int q = nwg / NXCD, r = nwg % NXCD, xcd = wgid % NXCD, off = wgid / NXCD;
    wgid = (xcd < r ? xcd * (q + 1) : r * (q + 1) + (xcd - r) * q) + off; }
  const int nig = WGM * nN, gid = wgid / nig, fm = gid * WGM, gsz = (nM - fm) < WGM ? (nM - fm) : WGM;
  u.pm = fm + ((wgid % nig) % gsz); u.pn = (wgid % nig) / gsz; return true;
}

enum { EPI_INPROJ = 0, EPI_GLU, EPI_OUTPROJ, EPI_FF1, EPI_FF2, EPI_POOL };

struct GemmDesc {
  const bf16_t* W; int ldw;
  const bf16_t* Act; int lda;
  int K, nN;
  int act_pn_step;
  int a_tstep;
  int a_kstep;
  int kind, layer;
};

DI void gemm_epilogue(PP p, const GemmDesc& d, const f32x4 (&acc)[2][2][4][2], const Unit& u, int wr, int wc, int fr, int fq) {
  const int m0 = u.pm * 256, n0 = u.pn * 256;
  const int tokb = m0 + wr * 64 + fr;
  const int nnb = n0 + wc * 32 + fq * 4;
  const float* modf = (const float*)(p->ws + OFF_MODF);
  switch (d.kind) {
    case EPI_INPROJ: {
      const int region = u.pn >> 1;
      const bool is_lat = m0 >= 4096;
      bf16_t* Qb = (bf16_t*)(p->ws + OFF_Q);
      bf16_t* Kb = (bf16_t*)(p->ws + OFF_K);
      bf16_t* Vf = (bf16_t*)(p->ws + OFF_V);
      float* U = (float*)(p->ws + OFF_U);
      float inv[4];
#pragma unroll
      for (int j = 0; j < 4; ++j) inv[j] = exp2f(-(float)(fq * 4 + j) * 0.8304820237218406f);
#pragma unroll
      for (int ai = 0; ai < 2; ++ai)
#pragma unroll
      for (int m = 0; m < 4; ++m) {
        const int tok = tokb + ai * 128 + m * 16;
        const int lt = (tok - 4096) & 2047;
        const float pos = (wc & 1) ? (float)(lt & 63) : (float)(lt >> 6);
        float cs[4], sn[4];
        if (region < 2 && is_lat) {
#pragma unroll
          for (int j = 0; j < 4; ++j) { float ang = pos * inv[j]; cs[j] = __cosf(ang); sn[j] = __sinf(ang); }
        }
#pragma unroll
        for (int bj = 0; bj < 2; ++bj) {
          f32x4 v[2] = {acc[ai][bj][m][0], acc[ai][bj][m][1]};
          if (region < 2 && is_lat) {
            const f32x4 x1 = v[0], x2 = v[1];
#pragma unroll
            for (int j = 0; j < 4; ++j) { v[0][j] = x1[j] * cs[j] - x2[j] * sn[j]; v[1][j] = x2[j] * cs[j] + x1[j] * sn[j]; }
          }
#pragma unroll
          for (int n = 0; n < 2; ++n) {
            const int nn = nnb + bj * 128 + n * 16;
            const f32x4 vv = v[n];
            if (region == 0) {
              u32x2 o = {pk2(vv[0], vv[1]), pk2(vv[2], vv[3])};
              *(u32x2*)(Qb + (size_t)tok * 512 + nn) = o;
            } else if (region == 1) {
              u32x2 o = {pk2(vv[0], vv[1]), pk2(vv[2], vv[3])};
              {
                const int c = nn - 512, h = c >> 7, mm = (c >> 6) & 1, dd = c & 63;
                int base, l, nkt;
                if (!is_lat) { base = tok & ~255; l = tok & 255; nkt = 8; }
                else { int t2 = tok - 4096; base = 4096 + (t2 >> 11) * 2560; l = t2 & 2047; nkt = 80; }
                *(u32x2*)(Kb + kf_off(base, nkt, h, mm, l >> 5, dd >> 4, 32 * ((dd >> 3) & 1) + (l & 31)) + (dd & 7)) = o;
              }
              if (!is_lat) *(f32x4*)(p->out + OUT_K + (size_t)tok * 512 + (nn - 512)) = vv;
            } else if (region == 2) {
              const int c = nn - 1024, h = c >> 7, dd0 = c & 127;
              int base, l, nkt;
              if (!is_lat) { base = tok & ~255; l = tok & 255; nkt = 8; }
              else { int t2 = tok - 4096; base = 4096 + (t2 >> 11) * 2560; l = t2 & 2047; nkt = 80; }
              const int kt = l >> 5, kk = l & 31, s = kk >> 4, j8 = 4 * ((kk >> 3) & 1) + (kk & 3), hh = (kk >> 2) & 1;
#pragma unroll
              for (int jj = 0; jj < 4; ++jj) {
                int dd = dd0 + jj;
                Vf[vf_off(base, nkt, h, kt, dd >> 5, s, 32 * hh + (dd & 31)) + j8] = f2bf(vv[jj]);
              }
              if (!is_lat) *(f32x4*)(p->out + OUT_V + (size_t)tok * 512 + c) = vv;
            } else {
              *(f32x4*)(U + (size_t)tok * 512 + (nn - 1536)) = vv;
            }
          }
        }
      }
    } break;
    case EPI_GLU: {
      const bf16_t* G = (const bf16_t*)(p->ws + OFF_GS5);
      bf16_t* cat = (bf16_t*)(p->ws + OFF_CAT);
#pragma unroll
      for (int ai = 0; ai < 2; ++ai)
#pragma unroll
      for (int bj = 0; bj < 2; ++bj)
#pragma unroll
      for (int m = 0; m < 4; ++m)
#pragma unroll
      for (int n = 0; n < 2; ++n) {
        const int tok = tokb + ai * 128 + m * 16, nn = nnb + bj * 128 + n * 16;
        const f32x4 v = acc[ai][bj][m][n];
        u32x2 gi = *(const u32x2*)(G + (size_t)tok * 512 + nn);
        float g0 = __uint_as_float(gi[0] << 16), g1 = __uint_as_float(gi[0] & 0xffff0000u);
        float g2 = __uint_as_float(gi[1] << 16), g3 = __uint_as_float(gi[1] & 0xffff0000u);
        u32x2 o = {pk2(g0 / (1.f + __expf(-v[0])), g1 / (1.f + __expf(-v[1]))),
                   pk2(g2 / (1.f + __expf(-v[2])), g3 / (1.f + __expf(-v[3])))};
        *(u32x2*)(cat + (size_t)tok * 1024 + 512 + nn) = o;
      }
    } break;
    case EPI_OUTPROJ: case EPI_FF2: case EPI_POOL: {
      float* X = (float*)(p->ws + OFF_X);
      const int jg = d.kind == EPI_FF2 ? 5 : 2;
      const float* gate = modf + (size_t)((d.layer * 5 + mod_row(m0)) * 6 + jg) * 1024;
#pragma unroll
      for (int ai = 0; ai < 2; ++ai)
#pragma unroll
      for (int bj = 0; bj < 2; ++bj)
#pragma unroll
      for (int m = 0; m < 4; ++m)
#pragma unroll
      for (int n = 0; n < 2; ++n) {
        const int tok = tokb + ai * 128 + m * 16, nn = nnb + bj * 128 + n * 16;
        f32x4 v = acc[ai][bj][m][n];
        f32x4 g = *(const f32x4*)(gate + nn);
        f32x4 xin;
        if (d.kind == EPI_OUTPROJ) {
          const float* xs = tok < 4096 ? p->x_prompt + (size_t)tok * 1024 : p->x_sample + (size_t)(tok - 4096) * 1024;
          xin = *(const f32x4*)(xs + nn);
        } else {
          xin = *(const f32x4*)(X + (size_t)tok * 1024 + nn);
        }
        if (d.kind == EPI_POOL) { f32x4 ps = *(const f32x4*)(p->pool_scale + nn); v = v * ps; }
        *(f32x4*)(X + (size_t)tok * 1024 + nn) = xin + g * v;
      }
    } break;
    case EPI_FF1: {
      bf16_t* H = (bf16_t*)(p->ws + OFF_H);
#pragma unroll
      for (int ai = 0; ai < 2; ++ai)
#pragma unroll
      for (int bj = 0; bj < 2; ++bj)
#pragma unroll
      for (int m = 0; m < 4; ++m)
#pragma unroll
      for (int n = 0; n < 2; ++n) {
        const int tok = tokb + ai * 128 + m * 16, nn = nnb + bj * 128 + n * 16;
        f32x4 v = acc[ai][bj][m][n];
        float r0 = fmaxf(v[0], 0.f), r1 = fmaxf(v[1], 0.f), r2 = fmaxf(v[2], 0.f), r3 = fmaxf(v[3], 0.f);
        u32x2 o = {pk2(r0 * r0, r1 * r1), pk2(r2 * r2, r3 * r3)};
        *(u32x2*)(H + ((size_t)((tok >> 8) * 64 + (nn >> 6)) * 256 + (tok & 255)) * 64 + (nn & 63)) = o;
      }
    } break;
  }
}

DI void gemm_phase(PP p, const GemmDesc& d) {
  const int tid = opaque_tid();
  LAS unsigned char* lds = (LAS unsigned char*)g_smem;
  const int wid = __builtin_amdgcn_readfirstlane(tid >> 6), lane = tid & 63, wr = wid >> 2, wc = wid & 3, fr = lane & 15, fq = lane >> 4;
  const int K = d.K, nt = K / BK;
  const int nM = 48, nN = d.nN, G = gridDim.x, cblk = blockIdx.x;
  unsigned voffA[2], voffB[2];
#pragma unroll
  for (int i = 0; i < 2; ++i) { int R, C; stage_rc(tid * 16 + i * 8192, R, C);
    voffA[i] = (unsigned)(R * d.lda + C) * 2u; voffB[i] = (unsigned)(R * d.ldw + C) * 2u; }
  const size_t kstep = (size_t)(BK * 2);
  const size_t kstepA = (size_t)d.a_kstep;
  const size_t hstepA = (size_t)HALF * d.lda * 2, hstepB = (size_t)HALF * d.ldw * 2;
  const size_t tstepA = d.a_tstep ? (size_t)d.a_tstep : 2 * hstepA, tstepB = 2 * hstepB;
  const unsigned ldsw = (unsigned)wid * 1024u;
  const int aoff = lds_byte(wr * 64 + fr, fq * 8), boff = lds_byte(wc * 32 + fr, fq * 8);
#define PG8_SA(b, h) (((b) * 2 + (h)) * HTB)
#define PG8_SB(b, h) ((4 + (b) * 2 + (h)) * HTB)
#define PG8_STAGE(bufoff, gbase, voff) do { _Pragma("unroll") for (int _i = 0; _i < 2; ++_i) \
    __builtin_amdgcn_global_load_lds((const unsigned*)((const char*)(gbase) + (voff)[_i]), (LAS unsigned*)(lds + (bufoff) + ldsw + _i * 8192), 16, 0, 0); } while (0)
#define PG8_LDA(dst, b, h) do { _Pragma("unroll") for (int m = 0; m < 4; ++m) _Pragma("unroll") for (int k = 0; k < 2; ++k) dst[m][k] = *(const LAS bf16x8*)(lds + PG8_SA(b, h) + aoff + m * 2048 + k * 1024); } while (0)
#define PG8_LDB(dst, b, h) do { _Pragma("unroll") for (int n = 0; n < 2; ++n) _Pragma("unroll") for (int k = 0; k < 2; ++k) dst[n][k] = *(const LAS bf16x8*)(lds + PG8_SB(b, h) + boff + n * 2048 + k * 1024); } while (0)
#define PG8_MMA(ai, bj, At, Bt) do { __builtin_amdgcn_s_setprio(1); _Pragma("unroll") for (int m = 0; m < 4; ++m) _Pragma("unroll") for (int n = 0; n < 2; ++n) _Pragma("unroll") for (int k = 0; k < 2; ++k) \
    acc[ai][bj][m][n] = __builtin_amdgcn_mfma_f32_16x16x32_bf16(Bt[n][k], At[m][k], acc[ai][bj][m][n], 0, 0, 0); __builtin_amdgcn_s_setprio(0); } while (0)
#define PG8_WAIT_V(n) asm volatile("s_waitcnt vmcnt(" #n ")" ::: "memory")
#define PG8_WAIT_L(n) asm volatile("s_waitcnt lgkmcnt(" #n ")" ::: "memory")
#define PG8_BAR __builtin_amdgcn_s_barrier()
#define PG8_SCHED __builtin_amdgcn_sched_barrier(0)
  Unit cur, nxt; int ui = 0;
  if (!unit_next(0, nM, nN, G, cblk, cur)) return;
  f32x4 acc[2][2][4][2];
#pragma unroll
  for (int a = 0; a < 2; ++a)
#pragma unroll
    for (int b = 0; b < 2; ++b)
#pragma unroll
      for (int m = 0; m < 4; ++m)
#pragma unroll
        for (int n = 0; n < 2; ++n) acc[a][b][m][n] = (f32x4){0.f, 0.f, 0.f, 0.f};
  bf16x8 At[4][2], B0[2][2], B1[2][2];
  const char* cA = (const char*)d.Act + (size_t)cur.pm * tstepA + (size_t)cur.pn * d.act_pn_step;
  const char* cB = (const char*)d.W + (size_t)cur.pn * tstepB;
  PG8_STAGE(PG8_SB(0, 0), cB, voffB); PG8_STAGE(PG8_SA(0, 0), cA, voffA); PG8_STAGE(PG8_SB(0, 1), cB + hstepB, voffB); PG8_STAGE(PG8_SA(0, 1), cA + hstepA, voffA);
  if (wr == 1) PG8_BAR;
  PG8_WAIT_V(4); PG8_BAR;
  PG8_STAGE(PG8_SB(1, 0), cB + kstep, voffB); PG8_STAGE(PG8_SA(1, 0), cA + kstepA, voffA); PG8_STAGE(PG8_SB(1, 1), cB + hstepB + kstep, voffB);
  PG8_WAIT_V(6); PG8_BAR;
  for (;;) {
    const bool has_next = unit_next(ui + 1, nM, nN, G, cblk, nxt);
    const char* nA = has_next ? (const char*)d.Act + (size_t)nxt.pm * tstepA + (size_t)nxt.pn * d.act_pn_step : cA;
    const char* nB = has_next ? (const char*)d.W + (size_t)nxt.pn * tstepB : cB;
    for (int t = 0; t < nt; t += 2) {
      const bool last = (t == nt - 2);
      const char* a1 = cA + (size_t)(t + 1) * kstepA;
      const char* a2 = last ? nA : cA + (size_t)(t + 2) * kstepA; const char* b2 = last ? nB : cB + (size_t)(t + 2) * kstep;
      const char* a3 = a2 + kstepA; const char* b3 = b2 + kstep;
      PG8_LDB(B0, 0, 0); PG8_SCHED; PG8_LDA(At, 0, 0); PG8_STAGE(PG8_SA(1, 1), a1 + hstepA, voffA);
      PG8_WAIT_L(8); PG8_BAR; PG8_WAIT_L(0); PG8_MMA(0, 0, At, B0); PG8_BAR; PG8_SCHED;
      PG8_LDB(B1, 0, 1); PG8_STAGE(PG8_SB(0, 0), b2, voffB);
      PG8_BAR; PG8_WAIT_L(0); PG8_MMA(0, 1, At, B1); PG8_BAR;
      PG8_LDA(At, 0, 1); PG8_STAGE(PG8_SA(0, 0), a2, voffA);
      PG8_BAR; PG8_WAIT_L(0); PG8_MMA(1, 0, At, B0); PG8_BAR; PG8_SCHED;
      PG8_STAGE(PG8_SB(0, 1), b2 + hstepB, voffB);
      PG8_WAIT_V(6); PG8_BAR; PG8_MMA(1, 1, At, B1); PG8_BAR;
      PG8_LDB(B0, 1, 0); PG8_SCHED; PG8_LDA(At, 1, 0); PG8_STAGE(PG8_SA(0, 1), a2 + hstepA, voffA);
      PG8_WAIT_L(8); PG8_BAR; PG8_WAIT_L(0); PG8_MMA(0, 0, At, B0); PG8_BAR; PG8_SCHED;
      PG8_LDB(B1, 1, 1); PG8_STAGE(PG8_SB(1, 0), b3, voffB);
      PG8_BAR; PG8_WAIT_L(0); PG8_MMA(0, 1, At, B1); PG8_BAR;
      PG8_LDA(At, 1, 1); PG8_STAGE(PG8_SA(1, 0), a3, voffA);
      PG8_BAR; PG8_WAIT_L(0); PG8_MMA(1, 0, At, B0); PG8_BAR; PG8_SCHED;
      PG8_STAGE(PG8_SB(1, 1), b3 + hstepB, voffB);
      PG8_WAIT_V(6); PG8_BAR; PG8_MMA(1, 1, At, B1); PG8_BAR;
    }
    gemm_epilogue(p, d, acc, cur, wr, wc, fr, fq);
    if (!has_next) break;
#pragma unroll
    for (int a = 0; a < 2; ++a)
#pragma unroll
      for (int b = 0; b < 2; ++b)
#pragma unroll
        for (int m = 0; m < 4; ++m)
#pragma unroll
          for (int n = 0; n < 2; ++n) acc[a][b][m][n] = (f32x4){0.f, 0.f, 0.f, 0.f};
    cur = nxt; cA = nA; cB = nB; ++ui;
  }
  PG8_WAIT_V(0);
  if (wr == 0) PG8_BAR;
  PG8_BAR;
}

#define MFMA32(a, b, c) __builtin_amdgcn_mfma_f32_32x32x16_bf16((a), (b), (c), 0, 0, 0)
#define MFMA16(a, b, c) __builtin_amdgcn_mfma_f32_16x16x32_bf16((a), (b), (c), 0, 0, 0)

struct AttnGeom { const bf16_t* qp; const bf16_t* kp; const bf16_t* vp; int qrow; int h; int nkt; };

DI AttnGeom attn_geom(PP p, bool is_lat, int b, int h, int qt, int lane) {
  const int r32 = lane & 31, hh = lane >> 5;
  const bf16_t* Qb = (const bf16_t*)(p->ws + OFF_Q);
  const bf16_t* Kb = (const bf16_t*)(p->ws + OFF_K);
  const bf16_t* Vf = (const bf16_t*)(p->ws + OFF_V);
  int tokbase, kvbase, nkt;
  if (!is_lat) { tokbase = b * 256; kvbase = b * 256; nkt = 8; }
  else { tokbase = 4096 + b * 2048; kvbase = 4096 + b * 2560; nkt = 80; }
  AttnGeom g;
  g.qrow = tokbase + 32 * qt + r32; g.h = h;
  g.qp = Qb + (size_t)g.qrow * 512 + h * 128 + 8 * hh;
  g.kp = Kb + kf_off(kvbase, nkt, h, 0, 0, 0, lane); g.nkt = nkt;
  g.vp = Vf + vf_off(kvbase, nkt, h, 0, 0, 0, lane);
  return g;
}
#define ATT_CS (0.125f * 1.4426950408889634f)
#define EXP2(x) __builtin_amdgcn_exp2f(x)
DI void attn_loadk(bf16x8 (&kc)[2][4], const bf16_t* kq, int nkt) {
#pragma unroll
  for (int m = 0; m < 2; ++m)
#pragma unroll
    for (int s = 0; s < 4; ++s) kc[m][s] = *(const bf16x8*)(kq + (size_t)m * nkt * 2048 + s * 512);
}
DI void attn_pass1(const AttnGeom& g, const bf16x8 (&Qf)[2][4], int kt0, int kt1, float (&mx)[2], float (&ls)[2]) {
  const float cs = ATT_CS;
  bf16x8 kc[2][4];
  attn_loadk(kc, g.kp + (size_t)kt0 * 2048, g.nkt);
#pragma unroll 1
  for (int kt = kt0; kt < kt1; ++kt) {
    f32x16 S[2];
#pragma unroll
    for (int m = 0; m < 2; ++m) {
#pragma unroll
      for (int i = 0; i < 16; ++i) S[m][i] = 0.f;
#pragma unroll
      for (int s = 0; s < 4; ++s) S[m] = MFMA32(kc[m][s], Qf[m][s], S[m]);
    }
    const int ktn = kt + 1 < kt1 ? kt + 1 : kt;
    attn_loadk(kc, g.kp + (size_t)ktn * 2048, g.nkt);
#pragma unroll
    for (int m = 0; m < 2; ++m) {
      float tm = S[m][0];
#pragma unroll
      for (int i = 1; i < 16; ++i) tm = fmaxf(tm, S[m][i]);
      float mn = fmaxf(mx[m], tm);
      float acc = ls[m] * EXP2((mx[m] - mn) * cs);
      float nb = -mn * cs;
#pragma unroll
      for (int i = 0; i < 16; ++i) acc += EXP2(fmaf(S[m][i], cs, nb));
      ls[m] = acc; mx[m] = mn;
    }
  }
}
DI void attn_pass2(const AttnGeom& g, const bf16x8 (&Qf)[2][4], int kt0, int kt1, const float (&nbias)[2], const float (&pscale)[2],
                   f32x16 (&O)[4]) {
  const float cs = ATT_CS;
  bf16x8 kc[2][4];
  attn_loadk(kc, g.kp + (size_t)kt0 * 2048, g.nkt);
#pragma unroll 1
  for (int kt = kt0; kt < kt1; ++kt) {
    const bf16_t* vq = g.vp + (size_t)kt * 4096;
    bf16x8 vf[8];
#pragma unroll
    for (int i = 0; i < 8; ++i) vf[i] = *(const bf16x8*)(vq + i * 512);
    f32x16 S0, S1;
#pragma unroll
    for (int i = 0; i < 16; ++i) { S0[i] = 0.f; S1[i] = 0.f; }
#pragma unroll
    for (int s = 0; s < 4; ++s) { S0 = MFMA32(kc[0][s], Qf[0][s], S0); S1 = MFMA32(kc[1][s], Qf[1][s], S1); }
    const int ktn = kt + 1 < kt1 ? kt + 1 : kt;
    attn_loadk(kc, g.kp + (size_t)ktn * 2048, g.nkt);
    float w[16];
#pragma unroll
    for (int i = 0; i < 16; ++i)
      w[i] = EXP2(fmaf(S0[i], cs, nbias[0])) * pscale[0] - EXP2(fmaf(S1[i], cs, nbias[1])) * pscale[1];
#pragma unroll
    for (int s = 0; s < 2; ++s) {
      u32x4 pw = {pk2(w[8 * s], w[8 * s + 1]), pk2(w[8 * s + 2], w[8 * s + 3]),
                  pk2(w[8 * s + 4], w[8 * s + 5]), pk2(w[8 * s + 6], w[8 * s + 7])};
      bf16x8 wf = __builtin_bit_cast(bf16x8, pw);
#pragma unroll
      for (int dt = 0; dt < 4; ++dt) O[dt] = MFMA32(vf[dt * 2 + s], wf, O[dt]);
    }
  }
}
DI void attn_finish(PP p, const AttnGeom& g, const f32x16 (&O)[4], int lane) {
  const int hh = lane >> 5;
  bf16_t* cat = (bf16_t*)(p->ws + OFF_CAT);
  float ss = 0.f;
#pragma unroll
  for (int dt = 0; dt < 4; ++dt)
#pragma unroll
    for (int i = 0; i < 16; ++i) ss += O[dt][i] * O[dt][i];
  ss += __shfl_xor(ss, 32);
  const float rstd = rsqrtf(ss * (1.f / 128.f) + 1e-6f) * 0.8f;
#pragma unroll
  for (int dt = 0; dt < 4; ++dt)
#pragma unroll
    for (int i4 = 0; i4 < 4; ++i4) {
      const int d0 = 32 * dt + 8 * i4 + 4 * hh;
      f32x4 gg = *(const f32x4*)(p->subln_g + d0);
      u32x2 o = {pk2(O[dt][4 * i4] * rstd * gg[0], O[dt][4 * i4 + 1] * rstd * gg[1]),
                 pk2(O[dt][4 * i4 + 2] * rstd * gg[2], O[dt][4 * i4 + 3] * rstd * gg[3])};
      *(u32x2*)(cat + (size_t)g.qrow * 1024 + g.h * 128 + d0) = o;
    }
}
DI void attn_loadq(const AttnGeom& g, bf16x8 (&Qf)[2][4]) {
#pragma unroll
  for (int m = 0; m < 2; ++m)
#pragma unroll
    for (int s = 0; s < 4; ++s) Qf[m][s] = *(const bf16x8*)(g.qp + m * 64 + 16 * s);
}

DI void attn_item_solo(PP p, int b, int h, int qt, float lam, const int tid) {
  const int lane = tid & 63;
  const AttnGeom g = attn_geom(p, false, b, h, qt, lane);
  bf16x8 Qf[2][4];
  attn_loadq(g, Qf);
  const float cs = ATT_CS;
  float mx[2] = {-1e30f, -1e30f}, ls[2] = {0.f, 0.f};
  attn_pass1(g, Qf, 0, 8, mx, ls);
  float nbias[2], pscale[2];
#pragma unroll
  for (int m = 0; m < 2; ++m) {
    float mo = __shfl_xor(mx[m], 32), lo = __shfl_xor(ls[m], 32);
    float M = fmaxf(mx[m], mo);
    float L = ls[m] * EXP2((mx[m] - M) * cs) + lo * EXP2((mo - M) * cs);
    nbias[m] = -M * cs;
    pscale[m] = (m == 0 ? 1.f : lam) / L;
  }
  f32x16 O[4];
#pragma unroll
  for (int dt = 0; dt < 4; ++dt)
#pragma unroll
    for (int i = 0; i < 16; ++i) O[dt][i] = 0.f;
  attn_pass2(g, Qf, 0, 8, nbias, pscale, O);
  attn_finish(p, g, O, lane);
}

#define ATT_STAGE 32768
#define ATT_WAITV(n) asm volatile("s_waitcnt vmcnt(" #n ")" ::: "memory")
#define ATT_BAR do { asm volatile("" ::: "memory"); __builtin_amdgcn_s_barrier(); asm volatile("" ::: "memory"); } while (0)
template <bool WITHV>
DI void attn_stage_issue(const bf16_t* kbh, const bf16_t* vbh, int t, int stage, int tid, LAS unsigned char* lds) {
  const int lane = tid & 63, wv = __builtin_amdgcn_readfirstlane(tid >> 6);
#pragma unroll
  for (int kh = 0; kh < 2; ++kh) {
    const int kt = kh * 40 + t;
    const bf16_t* ksrc = kbh + ((size_t)(((wv >> 2) * 80 + kt) * 4 + (wv & 3))) * 512 + lane * 8;
    __builtin_amdgcn_global_load_lds((const unsigned*)ksrc, (LAS unsigned*)(lds + stage * ATT_STAGE + kh * 16384 + wv * 1024), 16, 0, 0);
    if (WITHV) {
      const bf16_t* vsrc = vbh + (size_t)kt * 4096 + tid * 8;
      __builtin_amdgcn_global_load_lds((const unsigned*)vsrc, (LAS unsigned*)(lds + stage * ATT_STAGE + kh * 16384 + 8192 + wv * 1024), 16, 0, 0);
    }
  }
}

DI void attn_stage_issue2(const bf16_t* kbh, const bf16_t* vbh, int T, int stage, int tid, LAS unsigned char* lds) {
  const int lane = tid & 63, wv = __builtin_amdgcn_readfirstlane(tid >> 6);
#pragma unroll
  for (int j = 0; j < 2; ++j) {
    const int kt = 2 * T + j;
    const bf16_t* ksrc = kbh + ((size_t)(((wv >> 2) * 80 + kt) * 4 + (wv & 3))) * 512 + lane * 8;
    __builtin_amdgcn_global_load_lds((const unsigned*)ksrc, (LAS unsigned*)(lds + stage * ATT_STAGE + j * 16384 + wv * 1024), 16, 0, 0);
    const bf16_t* vsrc = vbh + (size_t)kt * 4096 + tid * 8;
    __builtin_amdgcn_global_load_lds((const unsigned*)vsrc, (LAS unsigned*)(lds + stage * ATT_STAGE + j * 16384 + 8192 + wv * 1024), 16, 0, 0);
  }
}

DI void attn_block(PP p, int base_item, float lam, const int tid) {
  LAS unsigned char* lds = (LAS unsigned char*)g_smem;
  const int lane = tid & 63, wid = __builtin_amdgcn_readfirstlane(tid >> 6), mp = wid & 1;
  const int item = base_item + (wid >> 1);
  const int b = item >> 8, h = (item >> 6) & 3;
  const AttnGeom g = attn_geom(p, true, b, h, item & 63, lane);
  const int kvbase = 4096 + b * 2560;
  const bf16_t* kbh = (const bf16_t*)(p->ws + OFF_K) + kf_off(kvbase, 80, h, 0, 0, 0, 0);
  const bf16_t* vbh = (const bf16_t*)(p->ws + OFF_V) + vf_off(kvbase, 80, h, 0, 0, 0, 0);
  float* odump = (float*)(g_smem + (wid >> 1) * 16384);
  bf16x8 Qf[4];
#pragma unroll
  for (int s = 0; s < 4; ++s) Qf[s] = *(const bf16x8*)(g.qp + mp * 64 + 16 * s);
  const float cs = ATT_CS;
  const float TAU = 8.0f / ATT_CS;
  const unsigned rdK = mp * 4096 + lane * 16, rdV = 8192 + lane * 16;
  float mrun = -1e30f, lsum = 0.f;
  f32x16 O[4];
#pragma unroll
  for (int dt = 0; dt < 4; ++dt)
#pragma unroll
    for (int i = 0; i < 16; ++i) O[dt][i] = 0.f;
#define MS_QK(SLOTP, DST) do { _Pragma("unroll") for (int i_ = 0; i_ < 16; ++i_) DST[i_] = 0.f; \
    _Pragma("unroll") for (int s_ = 0; s_ < 4; ++s_) DST = MFMA32(*(const LAS bf16x8*)((SLOTP) + rdK + s_ * 1024), Qf[s_], DST); } while (0)
#define MS_SOFTMAX(S) do { \
    float tm_ = S[0]; _Pragma("unroll") for (int i_ = 1; i_ < 16; ++i_) tm_ = fmaxf(tm_, S[i_]); \
    { auto sw_ = __builtin_amdgcn_permlane32_swap(__float_as_uint(tm_), __float_as_uint(tm_), false, false); tm_ = fmaxf(__uint_as_float(sw_[0]), __uint_as_float(sw_[1])); } \
    if (__any(tm_ > mrun + TAU)) { const float mn_ = fmaxf(mrun, tm_); const float al_ = EXP2((mrun - mn_) * cs); lsum *= al_; \
      _Pragma("unroll") for (int dt_ = 0; dt_ < 4; ++dt_) _Pragma("unroll") for (int i_ = 0; i_ < 16; ++i_) O[dt_][i_] *= al_; mrun = mn_; } \
    const float nb_ = -mrun * cs; float ac_ = 0.f; \
    _Pragma("unroll") for (int i_ = 0; i_ < 16; ++i_) { S[i_] = EXP2(fmaf(S[i_], cs, nb_)); ac_ += S[i_]; } \
    lsum += ac_; \
    _Pragma("unroll") for (int s_ = 0; s_ < 2; ++s_) { \
      u32x4 pw_ = {pk2(S[8 * s_], S[8 * s_ + 1]), pk2(S[8 * s_ + 2], S[8 * s_ + 3]), pk2(S[8 * s_ + 4], S[8 * s_ + 5]), pk2(S[8 * s_ + 6], S[8 * s_ + 7])}; \
      P[s_] = __builtin_bit_cast(bf16x8, pw_); } } while (0)
#define MS_PV(SLOTP) do { _Pragma("unroll") for (int s_ = 0; s_ < 2; ++s_) _Pragma("unroll") for (int dt_ = 0; dt_ < 4; ++dt_) \
    O[dt_] = MFMA32(*(const LAS bf16x8*)((SLOTP) + rdV + (dt_ * 2 + s_) * 1024), P[s_], O[dt_]); } while (0)
  ATT_BAR;
  attn_stage_issue2(kbh, vbh, 0, 0, tid, lds);
  attn_stage_issue2(kbh, vbh, 1, 1, tid, lds);
  attn_stage_issue2(kbh, vbh, 2, 2, tid, lds);
  ATT_WAITV(8);
  ATT_BAR;
  f32x16 Sa, Sb;
  MS_QK(lds, Sa);
#pragma unroll 1
  for (int T = 0; T < 40; ++T) {
    const LAS unsigned char* stc = lds + (T & 3) * ATT_STAGE;
    const LAS unsigned char* stn = lds + ((T + 1) & 3) * ATT_STAGE;
    if (T + 1 < 40) {
      if (T + 2 < 40) ATT_WAITV(4); else ATT_WAITV(0);
      ATT_BAR;
      if (T + 3 < 40) attn_stage_issue2(kbh, vbh, T + 3, (T + 3) & 3, tid, lds);
    }
    bf16x8 P[2];
    MS_QK(stc + 16384, Sb);
    MS_SOFTMAX(Sa);
    MS_PV(stc);
    if (T + 1 < 40) MS_QK(stn, Sa);
    MS_SOFTMAX(Sb);
    MS_PV(stc + 16384);
  }
  { auto sw_ = __builtin_amdgcn_permlane32_swap(__float_as_uint(lsum), __float_as_uint(lsum), false, false); lsum = __uint_as_float(sw_[0]) + __uint_as_float(sw_[1]); }
  const float sc = (mp == 0 ? 1.f : lam) / lsum;
  asm volatile("s_waitcnt lgkmcnt(0)" ::: "memory");
  ATT_BAR;
  if (mp) {
#pragma unroll
    for (int dt = 0; dt < 4; ++dt)
#pragma unroll
      for (int i = 0; i < 16; ++i) odump[(dt * 16 + i) * 64 + lane] = O[dt][i] * sc;
  }
  asm volatile("s_waitcnt lgkmcnt(0)" ::: "memory");
  ATT_BAR;
  if (!mp) {
#pragma unroll
    for (int dt = 0; dt < 4; ++dt)
#pragma unroll
      for (int i = 0; i < 16; ++i) O[dt][i] = O[dt][i] * sc - odump[(dt * 16 + i) * 64 + lane];
    attn_finish(p, g, O, lane);
  }
  asm volatile("s_waitcnt lgkmcnt(0)" ::: "memory");
  ATT_BAR;
}

constexpr int S5_BU_STRIDE = 132;
constexpr int S5_H_STRIDE = 136;
constexpr int S5_ROWS = 64;
constexpr int S5_WAVE_LDS = S5_ROWS * S5_H_STRIDE * 2;

DI float gelu_tanh(float x) {
  float z = 0.7978845608028654f * (x + 0.044715f * x * x * x);
  float e = __expf(2.f * z);
  float t = 1.f - 2.f / (e + 1.f);
  return 0.5f * x * (1.f + t);
}

template <bool FULL>
DI void s5_task(PP p, int gc, int g, const int tid) {
  const int lane = tid & 63, wid = tid >> 6, fr = lane & 15, fq = lane >> 4;
  bf16_t* Hs = (bf16_t*)(g_smem + wid * S5_WAVE_LDS);
  const float* U = (const float*)(p->ws + OFF_U);
  float* E = (float*)(p->ws + OFF_E);
  const bool is_lat = gc >= 64;
  int seqb, c, nc, gcbase;
  if (!is_lat) { seqb = gc >> 2; c = gc & 3; nc = 4; gcbase = gc & ~3; }
  else { seqb = (gc - 64) >> 5; c = (gc - 64) & 31; nc = 32; gcbase = 64 + ((gc - 64) & ~31); }
  const int t0 = gc * 64;
  f32x4 yacc[4];
#pragma unroll
  for (int i = 0; i < 4; ++i) yacc[i] = f32x4{0.f, 0.f, 0.f, 0.f};
  u32x4 ufa[4];
#pragma unroll
  for (int sc = 0; sc < 4; ++sc) {
    ufa[sc] = u32x4{0, 0, 0, 0};
    if (fq < 2) {
      const float* up = U + (size_t)(t0 + 16 * sc + fr) * 512 + 16 * g + 8 * fq;
      float4 v0 = *(const float4*)up, v1 = *(const float4*)(up + 4);
      ufa[sc] = u32x4{pk2(v0.x, v0.y), pk2(v0.z, v0.w), pk2(v1.x, v1.y), pk2(v1.z, v1.w)};
    }
  }

  float4 av2[2]; bf16x8 Bf2[2][8]; bf16x8 Cf2[2][4];
#pragma unroll
  for (int d2 = 0; d2 < 2; ++d2) {
    av2[d2] = ((const float4*)(p->ws + OFF_S5TA))[(d2 * 32 + g) * 64 + lane];
    const u32x4* tb = (const u32x4*)(p->ws + OFF_S5TB) + (size_t)((d2 * 32 + g) * 8) * 64 + lane;
#pragma unroll
    for (int nt = 0; nt < 8; ++nt) Bf2[d2][nt] = __builtin_bit_cast(bf16x8, tb[nt * 64]);
    if (FULL) {
      const u32x4* tc = (const u32x4*)(p->ws + OFF_S5TC) + (size_t)((d2 * 32 + g) * 4) * 64 + lane;
#pragma unroll
      for (int ks = 0; ks < 4; ++ks) Cf2[d2][ks] = __builtin_bit_cast(bf16x8, tc[ks * 64]);
    }
  }
#pragma unroll
  for (int dr = 0; dr < 2; ++dr) {
    const float4 av = av2[dr];
    const float a_re = av.x, a_im = av.y;
    float hre = 0.f, him = 0.f;
    if (FULL) {
      const float A64r = av.z, A64i = av.w;
      if (is_lat) {
        const float* h0 = p->state_s5 + ((size_t)((seqb * 2 + dr) * 32 + g) * 64 + lane) * 2;
        hre = h0[0]; him = h0[1];
      }
      {
        const int cnt = dr == 0 ? c : nc - 1 - c;
        const int j0 = dr == 0 ? gcbase : gcbase + nc - 1, js = dr == 0 ? 1 : -1;
        const float2* Eb = (const float2*)E + ((size_t)g * 2 + dr) * 64 + lane;
        for (int q0 = 0; q0 < cnt; q0 += 16) {
          float2 ev[16];
#pragma unroll
          for (int q = 0; q < 16; ++q) {
            const int jj = q0 + q < cnt ? j0 + js * (q0 + q) : j0;
            ev[q] = Eb[(size_t)jj * (32 * 2 * 64)];
          }
#pragma unroll
          for (int q = 0; q < 16; ++q) {
            if (q0 + q < cnt) {
              float tr, ti; cmul(A64r, A64i, hre, him, tr, ti);
              hre = tr + ev[q].x; him = ti + ev[q].y;
            }
          }
        }
      }
    }
    const bf16x8 (&Bf)[8] = Bf2[dr];
    const bf16x8 (&Cf)[4] = Cf2[dr];
    bf16_t* BH = Hs;
    wave_lds_sync();
#pragma unroll
    for (int tile = 0; tile < 4; ++tile) {
      const bf16x8 ufr = __builtin_bit_cast(bf16x8, ufa[tile]);
#pragma unroll
      for (int nt = 0; nt < 8; ++nt) {
        f32x4 z = {0.f, 0.f, 0.f, 0.f};
        f32x4 d = MFMA16(Bf[nt], ufr, z);
        u32x2 o = {pk2(d[0], d[1]), pk2(d[2], d[3])};
        *(u32x2*)(BH + (16 * tile + fr) * S5_H_STRIDE + 16 * nt + 4 * fq) = o;
      }
    }
    wave_lds_sync();
#pragma unroll 1
    for (int hh = 0; hh < 4; ++hh) {
      const int tile = dr == 0 ? hh : 3 - hh;
      float bre[16], bim[16];
#pragma unroll
      for (int t = 0; t < 16; ++t) { bre[t] = bf2f(BH[(16 * tile + t) * S5_H_STRIDE + lane]); bim[t] = bf2f(BH[(16 * tile + t) * S5_H_STRIDE + 64 + lane]); }
      asm volatile("s_waitcnt lgkmcnt(0)" ::: "memory");
      __builtin_amdgcn_wave_barrier();
      if (dr == 1) {
#pragma unroll
        for (int t = 0; t < 8; ++t) { float x = bre[t]; bre[t] = bre[15 - t]; bre[15 - t] = x; x = bim[t]; bim[t] = bim[15 - t]; bim[15 - t] = x; }
      }
      const int tsgn = dr == 0 ? 1 : -1, tbase = 16 * tile + (dr == 0 ? 0 : 15);
#pragma unroll
      for (int tt = 0; tt < 16; ++tt) {
        const int t = tbase + tsgn * tt;
        const float nre = fmaf(-a_im, him, fmaf(a_re, hre, bre[tt]));
        const float nim = fmaf(a_im, hre, fmaf(a_re, him, bim[tt]));
        hre = nre; him = nim;
        if (FULL) { BH[t * S5_H_STRIDE + lane] = f2bf(nre); BH[t * S5_H_STRIDE + 64 + lane] = f2bf(nim); }
      }
      asm volatile("" ::: "memory");
    }
    if (FULL) {
      wave_lds_sync();
#pragma unroll
      for (int tile = 0; tile < 4; ++tile)
#pragma unroll
        for (int ks = 0; ks < 4; ++ks) {
          bf16x8 hf = *(const bf16x8*)(BH + (16 * tile + fr) * S5_H_STRIDE + 32 * ks + 8 * fq);
          yacc[tile] = MFMA16(Cf[ks], hf, yacc[tile]);
        }
    }
    if (!FULL) {
      float* e = E + ((size_t)((gc * 32 + g) * 2 + dr) * 64 + lane) * 2;
      e[0] = hre; e[1] = him;
    } else if (!is_lat) {
      if ((dr == 0 && c == nc - 1) || (dr == 1 && c == 0)) {
        float* o = p->out + OUT_S + ((size_t)((seqb * 2 + dr) * 32 + g) * 64 + lane) * 2;
        o[0] = hre; o[1] = him;
      }
    }
  }
  if (FULL) {
    bf16_t* G = (bf16_t*)(p->ws + OFF_GS5);
    const f32x4 dsk = *(const f32x4*)(p->s5_d + 16 * g + 4 * fq);
#pragma unroll
    for (int sc = 0; sc < 4; ++sc) {
      const int tok = t0 + 16 * sc + fr;
      const f32x4 u = *(const f32x4*)(U + (size_t)tok * 512 + 16 * g + 4 * fq);
      f32x4 y = yacc[sc] + dsk * u;
      u32x2 o = {pk2(gelu_tanh(y[0]), gelu_tanh(y[1])), pk2(gelu_tanh(y[2]), gelu_tanh(y[3]))};
      *(u32x2*)(G + (size_t)tok * 512 + 16 * g + 4 * fq) = o;
    }
  }
}

DI void phase_attn_s5a(PP p, int part) {
  const int tid = opaque_tid();
  const int lane = tid & 63, wid = tid >> 6;
  float v1 = p->dl_qk[lane] * p->dl_qk[64 + lane], v2 = p->dl_qk[128 + lane] * p->dl_qk[192 + lane];
  v1 = wave_sum(v1); v2 = wave_sum(v2);
  const float lam = __uint_as_float((unsigned)__builtin_amdgcn_readfirstlane((int)__float_as_uint(expf(v1) - expf(v2) + 0.2f)));
  if (part != 2)
  {
    const int G = gridDim.x;
    const int lb = (G & 7) == 0 ? (blockIdx.x & 7) * (G >> 3) + (blockIdx.x >> 3) : blockIdx.x;
    for (int base = lb * 4; base < 1024; base += G * 4) attn_block(p, base, lam, tid);
  }
  if (part == 1) return;
  {
    const int tid2 = opaque_tid();
    const int lane2 = tid2 & 63;
    volatile unsigned* ctr = (volatile unsigned*)(g_smem + LDS_ST_OFF + 32);
    if (tid2 == 0) *ctr = 0u;
    __syncthreads();
    for (;;) {
      unsigned k = 0;
      if (lane2 == 0) k = atomicAdd((unsigned*)ctr, 1u);
      k = (unsigned)__builtin_amdgcn_readfirstlane((int)k);
      const int j = blockIdx.x + (int)k * gridDim.x;
      if (j >= 512 + 6144) break;
      if (j < 512) attn_item_solo(p, j >> 5, (j >> 3) & 3, j & 7, lam, tid2);
      else { int tsk = j - 512; s5_task<false>(p, tsk >> 5, tsk & 31, tid2); }
    }
  }
}
DI void phase_s5c(PP p) {
  const int tid = opaque_tid();
  const int wid = tid >> 6;
  const int nW = gridDim.x * 8, gw = blockIdx.x * 8 + wid;
  for (int tsk = gw; tsk < 6144; tsk += nW) s5_task<true>(p, tsk >> 5, tsk & 31, tid);
}

#define XB_TMO      128
#define XB_XCNT(j)  (256  + 64 * (j))
#define XB_XSUB(j)  (1280 + 64 * (j))
#define XB_XGEN(j)  (2304 + 64 * (j))
#define XB_TOP      3328
#define XB_TOPGEN   3392
#define XCD_BAR_WORDS 3456
#define XB_SPIN_CAP (1u << 18)
#define XLAS __attribute__((address_space(3)))
DI unsigned xb_ld(unsigned* p)              { return __hip_atomic_load(p, __ATOMIC_RELAXED, __HIP_MEMORY_SCOPE_AGENT); }
DI unsigned xb_add(unsigned* p, unsigned v) { return __hip_atomic_fetch_add(p, v, __ATOMIC_RELAXED, __HIP_MEMORY_SCOPE_AGENT); }
DI unsigned xb_xcc_id() { return (unsigned)__builtin_amdgcn_s_getreg((3 << 11) | 20) & 0xFu; }
#define XB_SPIN(cond, bar) do { unsigned _sp = 0; while (cond) { __builtin_amdgcn_s_sleep(1); \
    if ((++_sp & 255u) == 0u) { if (xb_ld(&(bar)[XB_TMO])) break; if (_sp > XB_SPIN_CAP) { atomicAdd(&(bar)[XB_TMO], 1u); break; } } } } while (0)
struct XcdBarrier { unsigned* bar; unsigned x; volatile XLAS unsigned* st; };
DI XcdBarrier xcd_barrier_post(unsigned* bar, volatile XLAS unsigned* st) {
  XcdBarrier b; b.bar = bar; b.x = xb_xcc_id(); b.st = st;
  if (threadIdx.x == 0) (void)xb_add(&bar[XB_XCNT(b.x)], 1u);
  return b;
}
DI void xcd_barrier_complete(unsigned* bar, unsigned x, unsigned& nloc, unsigned& nx) {
  const unsigned G = gridDim.x * gridDim.y * gridDim.z;
  unsigned sum, cnt, mine, sp = 0u;
  for (;;) {
    sum = 0u; cnt = 0u; mine = 0u;
#pragma unroll
    for (unsigned j = 0; j < 16; ++j) { const unsigned c = xb_ld(&bar[XB_XCNT(j)]); sum += c; cnt += (c > 0u) ? 1u : 0u; mine = (j == x) ? c : mine; }
    if (sum == G) break;
    __builtin_amdgcn_s_sleep(1);
    if ((++sp & 255u) == 0u) { if (xb_ld(&bar[XB_TMO])) break; if (sp > XB_SPIN_CAP) { atomicAdd(&bar[XB_TMO], 1u); break; } }
  }
  nloc = mine > 0u ? mine : 1u; nx = cnt > 0u ? cnt : 1u;
}
DI void xcd_barrier(const XcdBarrier& b) {
  asm volatile("s_waitcnt vmcnt(0)" ::: "memory");
  __syncthreads();
  if (threadIdx.x == 0) {
    unsigned* bar = b.bar;
    __builtin_amdgcn_s_waitcnt(0);
    unsigned nloc = b.st[0], nx = b.st[1];
    if (nloc == 0u) { xcd_barrier_complete(bar, b.x, nloc, nx); b.st[0] = nloc; b.st[1] = nx; }
    const unsigned old = xb_add(&bar[XB_XSUB(b.x)], 1u);
    const unsigned gen = old / nloc;
    if (old + 1u == (gen + 1u) * nloc) {
      __builtin_amdgcn_fence(__ATOMIC_RELEASE, "agent");
      asm volatile("s_waitcnt vmcnt(0)" ::: "memory");
      const unsigned og = xb_add(&bar[XB_TOP], 1u);
      const unsigned tg = og / nx;
      if (og + 1u == (tg + 1u) * nx) xb_add(&bar[XB_TOPGEN], 1u);
      else XB_SPIN(xb_ld(&bar[XB_TOPGEN]) == tg, bar);
      __builtin_amdgcn_fence(__ATOMIC_ACQUIRE, "agent");
      xb_add(&bar[XB_XGEN(b.x)], 1u);
      asm volatile("s_waitcnt vmcnt(0)" ::: "memory");
    } else {
      XB_SPIN(xb_ld(&bar[XB_XGEN(b.x)]) == gen, bar);
      __builtin_amdgcn_fence(__ATOMIC_ACQUIRE, "agent");
      asm volatile("s_waitcnt vmcnt(0)" ::: "memory");
    }
  }
  __syncthreads();
}

constexpr int N_PHASES = 18;
#define PANEL_CNT_WORD0 3584
#define NORM_FUSED (gridDim.x >= 192u)
#ifndef REP_PHASE
#define REP_PHASE -1
#endif
#ifndef REP_PART
#define REP_PART 0
#endif

template <int PH>
DI void run_phase() {
  const int rep = 0;
    PP p = get_pp();
    const float* Xw = (const float*)(p->ws + OFF_X);
    GemmDesc d;
    d.act_pn_step = 0; d.a_kstep = 128; d.a_tstep = 0; d.kind = -1; d.layer = 0;
    d.W = nullptr; d.Act = nullptr; d.ldw = 0; d.lda = 0; d.K = 0; d.nN = 0;
    switch (PH) {
      case 0: phase_mod_partial(p); break;
      case 1: phase_prep(p, 0, blockIdx.x, gridDim.x); break;
      case 2: phase_norm(p, p->x_prompt, p->x_sample, 0, 0, 0); break;
      case 3: d.W = (const bf16_t*)(p->ws + OFF_WIN); d.ldw = 1024; d.Act = (const bf16_t*)(p->ws + OFF_HN); d.lda = 1024;
              d.K = 1024; d.nN = 8; d.kind = EPI_INPROJ; d.layer = 0; break;
#ifndef NO_P4
      case 4: phase_attn_s5a(p, 0); break;
#endif
#ifndef NO_P5
      case 5: phase_s5c(p); break;
#endif
      case 6: d.W = (const bf16_t*)(p->ws + OFF_WGLU); d.ldw = 512; d.Act = (const bf16_t*)(p->ws + OFF_GS5); d.lda = 512;
              d.K = 512; d.nN = 2; d.kind = EPI_GLU; break;
      case 7: d.W = (const bf16_t*)(p->ws + OFF_WOUT); d.ldw = 1024; d.Act = (const bf16_t*)(p->ws + OFF_CAT); d.lda = 1024;
              d.K = 1024; d.nN = 4; d.kind = EPI_OUTPROJ; d.layer = 0; break;
      case 8: if (!NORM_FUSED) phase_norm(p, Xw, Xw + 4096ull * 1024, 0, 3, 0); break;
      case 9: d.W = (const bf16_t*)(p->ws + OFF_W1); d.ldw = 1024; d.Act = (const bf16_t*)(p->ws + OFF_HN); d.lda = 1024;
              d.K = 1024; d.nN = 16; d.kind = EPI_FF1; break;
      case 10: d.W = (const bf16_t*)(p->ws + OFF_W2); d.ldw = 4096; d.Act = (const bf16_t*)(p->ws + OFF_H); d.lda = 64; d.a_kstep = 32768; d.a_tstep = 2097152;
               d.K = 4096; d.nN = 4; d.kind = EPI_FF2; d.layer = 0; break;
      case 11: if (!NORM_FUSED) phase_norm(p, Xw, Xw + 4096ull * 1024, 1, 0, 1); break;
      case 12: phase_pool_z(p); break;
      case 13: d.W = (const bf16_t*)(p->ws + OFF_WPOOL); d.ldw = 256; d.Act = (const bf16_t*)(p->ws + OFF_HN); d.lda = 1024;
               d.K = 256; d.nN = 4; d.act_pn_step = 512; d.kind = EPI_POOL; d.layer = 1; break;
      case 14: if (!NORM_FUSED) phase_norm(p, Xw, Xw + 4096ull * 1024, 1, 3, 0); break;
      case 15: d.W = (const bf16_t*)(p->ws + OFF_W1) + 4194304ull; d.ldw = 1024; d.Act = (const bf16_t*)(p->ws + OFF_HN); d.lda = 1024;
               d.K = 1024; d.nN = 16; d.kind = EPI_FF1; break;
      case 16: d.W = (const bf16_t*)(p->ws + OFF_W2) + 4194304ull; d.ldw = 4096; d.Act = (const bf16_t*)(p->ws + OFF_H); d.lda = 64; d.a_kstep = 32768; d.a_tstep = 2097152;
               d.K = 4096; d.nN = 4; d.kind = EPI_FF2; d.layer = 1; break;
      case 17: if (!NORM_FUSED) phase_norm(p, Xw, Xw + 4096ull * 1024, 0, 0, 2); break;
    }
#ifndef NO_GEMM
    if (d.kind >= 0) gemm_phase(p, d);
#endif
    if ((PH == 7 || PH == 10 || PH == 13 || PH == 16) && NORM_FUSED) {
      Unit u;
      if (unit_next(0, 48, 4, gridDim.x, blockIdx.x, u)) {
        const int slot = PH == 7 ? 0 : PH == 10 ? 1 : PH == 13 ? 2 : 3;
        unsigned* cnt = (unsigned*)(p->ws + OFF_BAR) + PANEL_CNT_WORD0 + slot * 64 + u.pm;
        if (threadIdx.x == 0) {
          __builtin_amdgcn_fence(__ATOMIC_RELEASE, "agent");
          asm volatile("s_waitcnt vmcnt(0)" ::: "memory");
          (void)xb_add(cnt, 1u);
          unsigned spins = 0;
          while (xb_ld(cnt) < 4u) { __builtin_amdgcn_s_sleep(2); if (++spins > (1u << 22)) break; }
          __builtin_amdgcn_fence(__ATOMIC_ACQUIRE, "agent");
          asm volatile("s_waitcnt vmcnt(0)" ::: "memory");
        }
        __syncthreads();
        const int rb = u.pm * 256 + u.pn * 64;
        const int wv = (int)(threadIdx.x >> 6);
        if (PH == 7)  phase_norm(p, Xw, Xw + 4096ull * 1024, 0, 3, 0, rb, rb + 64, wv, 8);
        if (PH == 10) phase_norm(p, Xw, Xw + 4096ull * 1024, 1, 0, 1, rb, rb + 64, wv, 8);
        if (PH == 13) phase_norm(p, Xw, Xw + 4096ull * 1024, 1, 3, 0, rb, rb + 64, wv, 8);
        if (PH == 16) phase_norm(p, Xw, Xw + 4096ull * 1024, 0, 0, 2, rb, rb + 64, wv, 8);
      }
    }
    if (rep == 0) {
      if (PH == 3) {
        const int first = gridDim.x >> 1, nb = gridDim.x - first;
        if ((int)blockIdx.x >= first) {
          const int tid = opaque_tid();
          const int bid = blockIdx.x - first;
          for (int it = bid; it < 512; it += nb) transpose_item(p, it < 256 ? 224 + it : 736 + (it - 256), tid);
          phase_prep(p, 1, bid, nb);
        }
      }
      if (PH == 10) {
        const int first = (gridDim.x * 3) >> 2, nb = gridDim.x - first;
        if ((int)blockIdx.x >= first) {
          const int tid = opaque_tid();
          for (int it = blockIdx.x - first; it < 512; it += nb) transpose_item(p, it < 256 ? 480 + it : 992 + (it - 256), tid);
        }
      }
    }
}
template <int PH>
DI void run_from(cg::grid_group& grid) {
  if constexpr (PH < N_PHASES) {
    if constexpr (PH > 0) {
      XcdBarrier xb; xb.bar = (unsigned*)(get_pp()->ws + OFF_BAR); xb.x = xb_xcc_id();
      xb.st = (volatile XLAS unsigned*)((XLAS unsigned char*)g_smem + LDS_ST_OFF);
      if constexpr (PH == 1) { grid.sync(); if (threadIdx.x == 0) (void)xb_add(&xb.bar[XB_XCNT(xb.x)], 1u); }
      else if (!((PH == 8 || PH == 11 || PH == 14 || PH == 17) && NORM_FUSED)) xcd_barrier(xb);
    }
    if constexpr (PH == REP_PHASE && PH >= 2) {
      run_phase<PH>();
      XcdBarrier xb2; xb2.bar = (unsigned*)(get_pp()->ws + OFF_BAR); xb2.x = xb_xcc_id();
      xb2.st = (volatile XLAS unsigned*)((XLAS unsigned char*)g_smem + LDS_ST_OFF);
      xcd_barrier(xb2);
    }
    run_phase<PH>();
    run_from<PH + 1>(grid);
  }
}

__global__ void __launch_bounds__(NTHREADS) mega(Params pk) {
  cg::grid_group grid = cg::this_grid();
  unsigned* bar = (unsigned*)(get_pp()->ws + OFF_BAR);
  volatile XLAS unsigned* st = (volatile XLAS unsigned*)((XLAS unsigned char*)g_smem + LDS_ST_OFF);
  if (threadIdx.x == 0) { st[0] = 0u; st[1] = 0u; st[2] = 0u; st[3] = 0u; }
  if (blockIdx.x == 0) {
    for (int i = threadIdx.x; i < 4096; i += NTHREADS) __hip_atomic_store(&bar[i], 0u, __ATOMIC_RELAXED, __HIP_MEMORY_SCOPE_AGENT);
    __threadfence();
  }
  __syncthreads();
  run_from<0>(grid);
}

extern "C" void kernel_launch(void* const* d_in, const int* in_sizes, int n_in, void* d_out, int out_size,
                              void* d_ws, size_t ws_size, hipStream_t stream) {
  static int grid_blocks = 0;
  if (!grid_blocks) {
    int dev = 0, cus = 0, per_cu = 0;
    hipGetDevice(&dev);
    hipFuncSetAttribute((const void*)mega, hipFuncAttributeMaxDynamicSharedMemorySize, SHM_BYTES);
    hipDeviceGetAttribute(&cus, hipDeviceAttributeMultiprocessorCount, dev);
    hipOccupancyMaxActiveBlocksPerMultiprocessor(&per_cu, mega, NTHREADS, SHM_BYTES);
    if (per_cu > 1) per_cu = 1;
    grid_blocks = cus * per_cu;
  }
  if (ws_size < WS_NEEDED) fprintf(stderr, "workspace too small: %zu < %zu\n", ws_size, (size_t)WS_NEEDED);
  Params p{};
  const float** pf = (const float**)&p;
  for (int i = 0; i < 28; ++i) pf[i] = (const float*)d_in[i];
  p.out = (float*)d_out;
  p.ws = (char*)d_ws;
  p.phase_lo = 0;
  p.phase_hi = N_PHASES;
  p.rep_phase = -1;
  void* args[] = {&p};
  hipError_t e = hipLaunchCooperativeKernel((void*)mega, dim3(grid_blocks), dim3(NTHREADS), args, SHM_BYTES, stream);
  if (e != hipSuccess) fprintf(stderr, "cooperative launch failed: %s (grid %d)\n", hipGetErrorString(e), grid_blocks);
}
```

```cpp
#include <hip/hip_runtime.h>
#include <hip/hip_cooperative_groups.h>
#include <cstdio>
namespace cg = cooperative_groups;

#define DI __device__ __forceinline__
typedef unsigned short bf16_t;
using bf16x8 = __attribute__((ext_vector_type(8))) short;
using f32x4  = __attribute__((ext_vector_type(4))) float;
using f32x16 = __attribute__((ext_vector_type(16))) float;
using u32x4  = __attribute__((ext_vector_type(4))) unsigned;
using u32x2  = __attribute__((ext_vector_type(2))) unsigned;
typedef __bf16 bf2_t __attribute__((ext_vector_type(2)));
typedef float fl2_t __attribute__((ext_vector_type(2)));

constexpr int NTHREADS = 512;
constexpr int T_ALL = 12288;
constexpr int LDS_ST_OFF = 139264;
constexpr int LDS_STATS_OFF = LDS_ST_OFF + 64;
constexpr int SHM_BYTES = LDS_STATS_OFF + 4096;

constexpr size_t OFF_MODP = 0;
constexpr size_t SZ_MODP  = 32ull * 2 * 5 * 6144 * 4;
constexpr size_t OFF_MODF = OFF_MODP + SZ_MODP;
constexpr size_t SZ_MODF  = 2ull * 5 * 6 * 1024 * 4;
constexpr size_t OFF_WIN  = OFF_MODF + SZ_MODF;
constexpr size_t SZ_WIN   = 2048ull * 1024 * 2;
constexpr size_t OFF_WOUT = OFF_WIN + SZ_WIN;
constexpr size_t SZ_WOUT  = 1024ull * 1024 * 2;
constexpr size_t OFF_WGLU = OFF_WOUT + SZ_WOUT;
constexpr size_t SZ_WGLU  = 512ull * 512 * 2;
constexpr size_t OFF_WPOOL = OFF_WGLU + SZ_WGLU;
constexpr size_t SZ_WPOOL = 4ull * 256 * 256 * 2;
constexpr size_t OFF_W1   = OFF_WPOOL + SZ_WPOOL;
constexpr size_t SZ_W1    = 2ull * 4096 * 1024 * 2;
constexpr size_t OFF_W2   = OFF_W1 + SZ_W1;
constexpr size_t SZ_W2    = 2ull * 1024 * 4096 * 2;
constexpr size_t OFF_HN   = OFF_W2 + SZ_W2;
constexpr size_t SZ_HN    = 12288ull * 1024 * 2;
constexpr size_t OFF_X    = OFF_HN + SZ_HN;
constexpr size_t SZ_X     = 12288ull * 1024 * 4;
constexpr size_t OFF_RSTD = OFF_X + SZ_X;
constexpr size_t SZ_RSTD  = 12288ull * 4;
constexpr size_t OFF_S5TA = OFF_RSTD + SZ_RSTD;
constexpr size_t SZ_S5TA  = 2ull * 32 * 64 * 16;
constexpr size_t OFF_S5TB = OFF_S5TA + SZ_S5TA;
constexpr size_t SZ_S5TB  = 2ull * 32 * 8 * 64 * 16;
constexpr size_t OFF_S5TC = OFF_S5TB + SZ_S5TB;
constexpr size_t SZ_S5TC  = 2ull * 32 * 4 * 64 * 16;
constexpr size_t OFF_BAR  = OFF_S5TC + SZ_S5TC;
constexpr size_t SZ_BAR   = 16384;
constexpr size_t OFF_R    = OFF_BAR + SZ_BAR;
constexpr size_t OFF_Q    = OFF_R;
constexpr size_t SZ_Q     = 12288ull * 512 * 2;
constexpr size_t OFF_K    = OFF_Q + SZ_Q;
constexpr size_t SZ_K     = 14336ull * 512 * 2;
constexpr size_t OFF_V    = OFF_K + SZ_K;
constexpr size_t SZ_V     = SZ_K;
constexpr size_t OFF_U    = OFF_V + SZ_V;
constexpr size_t SZ_U     = 12288ull * 512 * 4;
constexpr size_t OFF_E    = OFF_U + SZ_U;
constexpr size_t SZ_E     = 192ull * 32 * 2 * 64 * 2 * 4;
constexpr size_t OFF_GS5  = OFF_E + SZ_E;
constexpr size_t SZ_GS5   = 12288ull * 512 * 2;
constexpr size_t OFF_CAT  = OFF_GS5 + SZ_GS5;
constexpr size_t SZ_CAT   = 12288ull * 1024 * 2;
constexpr size_t END_MIX  = OFF_CAT + SZ_CAT;
constexpr size_t OFF_H    = OFF_R;
constexpr size_t SZ_H     = 12288ull * 4096 * 2;
constexpr size_t END_H    = OFF_H + SZ_H;
constexpr size_t WS_NEEDED = END_MIX > END_H ? END_MIX : END_H;

constexpr size_t OUT_Y  = 0;
constexpr size_t OUT_K  = 12288ull * 1024;
constexpr size_t OUT_V  = OUT_K + 4096ull * 512;
constexpr size_t OUT_S  = OUT_V + 4096ull * 512;

struct Params {
  const float *x_prompt, *x_sample, *cache_k, *cache_v, *state_s5, *c, *c_ctx, *mod_w, *mod_b, *norm_g,
      *w_in, *w_out, *dl_qk, *subln_g, *lam_re, *lam_im, *log_dt, *b_re, *b_im, *c_re, *c_im, *s5_d, *w_glu,
      *pool_w, *pool_scale, *ff_w1, *ff_w2, *final_g;
  float* out;
  char* ws;
  int phase_lo, phase_hi;
  int rep_phase, pad0;
};

typedef const Params __attribute__((address_space(4)))* PP;
extern __shared__ __attribute__((aligned(16))) char g_smem[];
DI PP get_pp() { PP kp = (PP)__builtin_amdgcn_kernarg_segment_ptr(); asm volatile("" : "+s"(kp)); return kp; }

DI unsigned pk2(float a, float b) {
  fl2_t f = {a, b};
  bf2_t r = __builtin_convertvector(f, bf2_t);
  return __builtin_bit_cast(unsigned, r);
}
DI bf16_t f2bf(float a) { return (bf16_t)(pk2(a, 0.f) & 0xffffu); }
DI float bf2f(bf16_t v) { return __uint_as_float(((unsigned)v) << 16); }
DI void wave_lds_sync() { asm volatile("s_waitcnt lgkmcnt(0)" ::: "memory"); __builtin_amdgcn_wave_barrier(); }
DI float wave_sum(float v) {
  v += __shfl_xor(v, 32); v += __shfl_xor(v, 16); v += __shfl_xor(v, 8);
  v += __shfl_xor(v, 4);  v += __shfl_xor(v, 2);  v += __shfl_xor(v, 1);
  return v;
}
DI int opaque_tid() { int t = threadIdx.x; asm volatile("" : "+v"(t)); return t; }
DI int mod_row(int tok) { return tok < 4096 ? 0 : 1 + ((tok - 4096) >> 11); }
DI int kv_row(int tok) {
  if (tok < 4096) return tok;
  int b = (tok - 4096) >> 11, l = (tok - 4096) & 2047;
  return 4096 + b * 2560 + l;
}
DI size_t vf_off(int base_rows, int nkt, int h, int kt, int dt, int s, int lane) {
  return (size_t)base_rows * 512 + ((((size_t)(h * nkt + kt) * 4 + dt) * 2 + s) * 64 + lane) * 8;
}

DI size_t kf_off(int base_rows, int nkt, int h, int m, int kt, int s, int lane) {
  return (size_t)base_rows * 512 + ((((size_t)((h * 2 + m) * nkt + kt)) * 4 + s) * 64 + lane) * 8;
}

DI void phase_mod_partial(PP p) {
  const int tid = opaque_tid();
  float* s_silu = (float*)g_smem;
  float* modp = (float*)(p->ws + OFF_MODP);
  const int nitems = 2 * 12 * 32;
  for (int it = blockIdx.x; it < nitems; it += gridDim.x) {
    int ks = it & 31, cc = (it >> 5) % 12, l = it / (32 * 12);
    __syncthreads();
    if (tid < 160) {
      int r = tid >> 5, k = tid & 31, kk = ks * 32 + k;
      float v = r == 0 ? p->c_ctx[kk] : p->c[(r - 1) * 1024 + kk];
      s_silu[tid] = v / (1.f + expf(-v));
    }
    __syncthreads();
    int n = cc * 512 + tid;
    const float* w = p->mod_w + ((size_t)l * 1024 + ks * 32) * 6144 + n;
    float a0 = 0, a1 = 0, a2 = 0, a3 = 0, a4 = 0;
#pragma unroll 8
    for (int k = 0; k < 32; ++k) {
      float wv = __builtin_nontemporal_load(w + (size_t)k * 6144);
      a0 += s_silu[k] * wv; a1 += s_silu[32 + k] * wv; a2 += s_silu[64 + k] * wv;
      a3 += s_silu[96 + k] * wv; a4 += s_silu[128 + k] * wv;
    }
    float* o = modp + ((size_t)(ks * 2 + l) * 5) * 6144 + n;
    o[0] = a0; o[6144] = a1; o[2 * 6144] = a2; o[3 * 6144] = a3; o[4 * 6144] = a4;
  }
}

DI void transpose_tile4(const float* __restrict__ src, int K, int N, bf16_t* __restrict__ dst, int tk, int tn4, int tid) {
  float* tile = (float*)g_smem;
  float4 v[8];
#pragma unroll
  for (int i = 0; i < 8; ++i) {
    int idx = tid + 512 * i, r = idx >> 6, c4 = (idx & 63) * 4;
    { const f32x4 t_ = __builtin_nontemporal_load((const f32x4*)(src + (size_t)(tk * 64 + r) * N + tn4 * 256 + c4)); v[i] = float4{t_[0], t_[1], t_[2], t_[3]}; }
  }
  __syncthreads();
#pragma unroll
  for (int i = 0; i < 8; ++i) {
    int idx = tid + 512 * i, r = idx >> 6, c4 = (idx & 63) * 4;
    float* t = tile + (c4 >> 6) * (64 * 65) + r * 65 + (c4 & 63);
    t[0] = v[i].x; t[1] = v[i].y; t[2] = v[i].z; t[3] = v[i].w;
  }
  __syncthreads();
#pragma unroll
  for (int q = 0; q < 4; ++q) {
    int n = tid >> 3, kc = tid & 7;
    const float* t = tile + q * (64 * 65);
    u32x4 o;
    for (int j = 0; j < 4; ++j)
      o[j] = pk2(t[(kc * 8 + 2 * j) * 65 + n], t[(kc * 8 + 2 * j + 1) * 65 + n]);
    *(u32x4*)(dst + (size_t)(tn4 * 256 + q * 64 + n) * K + tk * 64 + kc * 8) = o;
  }
}

DI void cmul(float ar, float ai, float br, float bi, float& cr, float& ci) { cr = ar * br - ai * bi; ci = ar * bi + ai * br; }
DI void s5_disc(PP p, int dr, int g, int pp, float& a_re, float& a_im, float& f_re, float& f_im) {
  const int idx = (dr * 32 + g) * 64 + pp;
  const float lr = p->lam_re[idx], li = p->lam_im[idx];
  const float dt = expf(p->log_dt[dr * 32 + g]);
  const float mag = expf(lr * dt), ang = li * dt;
  a_re = mag * cosf(ang); a_im = mag * sinf(ang);
  const float den = lr * lr + li * li;
  f_re = ((a_re - 1.f) * lr + a_im * li) / den;
  f_im = (a_im * lr - (a_re - 1.f) * li) / den;
}

DI void s5_build_tables(PP p, int dr, int g, int lane) {
  const int fr = lane & 15, fq = lane >> 4;
  float a_re, a_im, f_re, f_im;
  s5_disc(p, dr, g, lane, a_re, a_im, f_re, f_im);
  float A64r = a_re, A64i = a_im;
#pragma unroll
  for (int i = 0; i < 6; ++i) { float tr, ti; cmul(A64r, A64i, A64r, A64i, tr, ti); A64r = tr; A64i = ti; }
  ((float4*)(p->ws + OFF_S5TA))[(dr * 32 + g) * 64 + lane] = float4{a_re, a_im, A64r, A64i};
  u32x4* tb = (u32x4*)(p->ws + OFF_S5TB) + (size_t)((dr * 32 + g) * 8) * 64 + lane;
#pragma unroll
  for (int nt = 0; nt < 4; ++nt) {
    float are, aim, fre, fim;
    const int pp = 16 * nt + fr;
    s5_disc(p, dr, g, pp, are, aim, fre, fim);
    u32x4 ore = {0, 0, 0, 0}, oim = {0, 0, 0, 0};
    if (fq < 2) {
      const size_t bo = ((size_t)((dr * 32 + g) * 64 + pp)) * 16 + 8 * fq;
      float br[8], bi[8];
      *(float4*)&br[0] = *(const float4*)(p->b_re + bo); *(float4*)&br[4] = *(const float4*)(p->b_re + bo + 4);
      *(float4*)&bi[0] = *(const float4*)(p->b_im + bo); *(float4*)&bi[4] = *(const float4*)(p->b_im + bo + 4);
#pragma unroll
      for (int j = 0; j < 4; ++j) {
        float r0 = fre * br[2 * j] - fim * bi[2 * j], r1 = fre * br[2 * j + 1] - fim * bi[2 * j + 1];
        float i0 = fre * bi[2 * j] + fim * br[2 * j], i1 = fre * bi[2 * j + 1] + fim * br[2 * j + 1];
        ore[j] = pk2(r0, r1); oim[j] = pk2(i0, i1);
      }
    }
    tb[nt * 64] = ore; tb[(4 + nt) * 64] = oim;
  }
  u32x4* tc = (u32x4*)(p->ws + OFF_S5TC) + (size_t)((dr * 32 + g) * 4) * 64 + lane;
#pragma unroll
  for (int ks = 0; ks < 4; ++ks) {
    const int k0 = 32 * ks + 8 * fq;
    const float* src = (k0 < 64 ? p->c_re : p->c_im) + ((size_t)((dr * 32 + g) * 16 + fr)) * 64 + (k0 & 63);
    const float sg = k0 < 64 ? 1.f : -1.f;
    float4 v0 = *(const float4*)src, v1 = *(const float4*)(src + 4);
    tc[ks * 64] = u32x4{pk2(sg * v0.x, sg * v0.y), pk2(sg * v0.z, sg * v0.w), pk2(sg * v1.x, sg * v1.y), pk2(sg * v1.z, sg * v1.w)};
  }
}

DI void transpose_item(PP p, int tix, int tid) {
  const float* src; bf16_t* dst; int K, N, local;
  if (tix < 128) { src = p->w_in; K = 1024; N = 2048; dst = (bf16_t*)(p->ws + OFF_WIN); local = tix; }
  else if (tix < 192) { src = p->w_out; K = 1024; N = 1024; dst = (bf16_t*)(p->ws + OFF_WOUT); local = tix - 128; }
  else if (tix < 208) { src = p->w_glu; K = 512; N = 512; dst = (bf16_t*)(p->ws + OFF_WGLU); local = tix - 192; }
  else if (tix < 224) { int g = (tix - 208) >> 2; src = p->pool_w + (size_t)g * 65536; K = 256; N = 256;
                        dst = (bf16_t*)(p->ws + OFF_WPOOL) + (size_t)g * 65536; local = (tix - 208) & 3; }
  else if (tix < 736) { int l = (tix - 224) >> 8; src = p->ff_w1 + (size_t)l * 4194304; K = 1024; N = 4096;
                        dst = (bf16_t*)(p->ws + OFF_W1) + (size_t)l * 4194304; local = (tix - 224) & 255; }
  else { int l = (tix - 736) >> 8; src = p->ff_w2 + (size_t)l * 4194304; K = 4096; N = 1024;
         dst = (bf16_t*)(p->ws + OFF_W2) + (size_t)l * 4194304; local = (tix - 736) & 255; }
  int tpr = N >> 8;
  transpose_tile4(src, K, N, dst, local / tpr, local % tpr, tid);
}

DI void phase_prep(PP p, int part, int bid, int nb) {
  const int tid = opaque_tid();
  const float* modp = (const float*)(p->ws + OFF_MODP);
  float* modf = (float*)(p->ws + OFF_MODF);
  const int N_FIN = 120, N_TR = 224, N_CK = 256, N_CV = 256, N_S5 = 8;
  const int nitems = N_FIN + N_TR + N_CK + N_CV + N_S5;
  const int it_lo = part == 0 ? 0 : N_FIN + N_TR, it_hi = part == 0 ? N_FIN + N_TR : nitems;
  for (int it = it_lo + bid; it < it_hi; it += nb) {
    if (it < N_FIN) {
      const int idx = it * 512 + tid;
      const int l = idx / 30720, rem = idx - l * 30720, r = rem / 6144, c = rem - r * 6144, j = c >> 10, n = c & 1023;
      float part[32];
#pragma unroll
      for (int ks = 0; ks < 32; ++ks) part[ks] = modp[((size_t)(ks * 2 + l) * 5 + r) * 6144 + c];
      float sum = p->mod_b[l * 6144 + c];
#pragma unroll
      for (int ks = 0; ks < 32; ++ks) sum += part[ks];
      float* o = modf + (size_t)((l * 5 + r) * 6) * 1024 + n;
      if (j == 0) o[1024] = sum;
      else if (j == 1) o[0] = p->norm_g[(l * 2 + 0) * 1024 + n] * (1.f + sum);
      else if (j == 2) o[2 * 1024] = sum;
      else if (j == 3) o[4 * 1024] = sum;
      else if (j == 4) o[3 * 1024] = p->norm_g[(l * 2 + 1) * 1024 + n] * (1.f + sum);
      else o[5 * 1024] = sum;
    } else if (it < N_FIN + N_TR) {
      transpose_item(p, it - N_FIN, tid);
    } else if (it < N_FIN + N_TR + N_CK) {
      int idx = (it - N_FIN - N_TR) * 512 + tid;
      int lane = idx & 63, s = (idx >> 6) & 3, kt16 = (idx >> 8) & 15, mm = (idx >> 12) & 1, h = (idx >> 13) & 3, b = idx >> 15;
      int key = 32 * kt16 + (lane & 31), hh = lane >> 5;
      const float* src = p->cache_k + ((size_t)(b * 512 + key) * 4 + h) * 128 + mm * 64 + 16 * s + 8 * hh;
      float4 v0 = *(const float4*)src, v1 = *(const float4*)(src + 4);
      u32x4 o = {pk2(v0.x, v0.y), pk2(v0.z, v0.w), pk2(v1.x, v1.y), pk2(v1.z, v1.w)};
      bf16_t* Kb = (bf16_t*)(p->ws + OFF_K);
      *(u32x4*)(Kb + kf_off(4096 + b * 2560, 80, h, mm, 64 + kt16, s, lane)) = o;
    } else if (it >= N_FIN + N_TR + N_CK + N_CV) {
      const int w = (it - (N_FIN + N_TR + N_CK + N_CV)) * 8 + (tid >> 6);
      s5_build_tables(p, w >> 5, w & 31, tid & 63);
    } else {
      int idx = (it - N_FIN - N_TR - N_CK) * 512 + tid;
      int lane = idx & 63, s = (idx >> 6) & 1, dt = (idx >> 7) & 3, kt16 = (idx >> 9) & 15, h = (idx >> 13) & 3, b = idx >> 15;
      int hh = lane >> 5, dd = 32 * dt + (lane & 31);
      float v[8];
#pragma unroll
      for (int j = 0; j < 8; ++j) {
        int kk = 16 * s + 8 * (j >> 2) + 4 * hh + (j & 3);
        int key = 32 * kt16 + kk;
        v[j] = p->cache_v[((size_t)(b * 512 + key) * 4 + h) * 128 + dd];
      }
      u32x4 o = {pk2(v[0], v[1]), pk2(v[2], v[3]), pk2(v[4], v[5]), pk2(v[6], v[7])};
      bf16_t* Vf = (bf16_t*)(p->ws + OFF_V);
      *(u32x4*)(Vf + vf_off(4096 + b * 2560, 80, h, 64 + kt16, dt, s, lane)) = o;
    }
  }
}

DI void phase_norm(PP p, const float* xa, const float* xb, int layer, int jalpha, int mode, int rbeg = 0, int rend = T_ALL, int widx = -1, int nwv = 0) {
  const int tid = opaque_tid();
  const int lane = tid & 63, wid = tid >> 6;
  const int nW = widx < 0 ? gridDim.x * 8 : nwv, gw = widx < 0 ? (int)blockIdx.x * 8 + wid : rbeg + widx;
  const int T_END = rend;
  const float* modf = (const float*)(p->ws + OFF_MODF);
  bf16_t* hn = (bf16_t*)(p->ws + OFF_HN);
  float* rstd_buf = (float*)(p->ws + OFF_RSTD);
  constexpr int R = 3;
  for (int row0 = gw; row0 < T_END; row0 += nW * R) {
    float4 v[R][4];
    float ss[R];
#pragma unroll
    for (int r = 0; r < R; ++r) {
      const int row = row0 + r * nW;
      ss[r] = 0.f;
      if (row < T_END) {
        const float* x = row < 4096 ? xa + (size_t)row * 1024 : xb + (size_t)(row - 4096) * 1024;
#pragma unroll
        for (int i = 0; i < 4; ++i) v[r][i] = *(const float4*)(x + i * 256 + lane * 4);
      } else {
#pragma unroll
        for (int i = 0; i < 4; ++i) v[r][i] = float4{0.f, 0.f, 0.f, 0.f};
      }
    }
#pragma unroll
    for (int r = 0; r < R; ++r) {
#pragma unroll
      for (int i = 0; i < 4; ++i)
        ss[r] += v[r][i].x * v[r][i].x + v[r][i].y * v[r][i].y + v[r][i].z * v[r][i].z + v[r][i].w * v[r][i].w;
      ss[r] = wave_sum(ss[r]);
    }
#pragma unroll
    for (int r = 0; r < R; ++r) {
      const int row = row0 + r * nW;
      if (row >= T_END) continue;
      const float rstd = rsqrtf(ss[r] * (1.f / 1024.f) + 1e-6f);
      if (mode == 1) { if (lane == 0) rstd_buf[row] = rstd; continue; }
      if (mode == 2) {
#pragma unroll
        for (int i = 0; i < 4; ++i) {
          float4 g = *(const float4*)(p->final_g + i * 256 + lane * 4);
          float4 o = {v[r][i].x * rstd * g.x, v[r][i].y * rstd * g.y, v[r][i].z * rstd * g.z, v[r][i].w * rstd * g.w};
          *(float4*)(p->out + OUT_Y + (size_t)row * 1024 + i * 256 + lane * 4) = o;
        }
        continue;
      }
      const float* al = modf + (size_t)((layer * 5 + mod_row(row)) * 6 + jalpha) * 1024;
      const float* be = al + 1024;
#pragma unroll
      for (int i = 0; i < 4; ++i) {
        float4 a = *(const float4*)(al + i * 256 + lane * 4);
        float4 b = *(const float4*)(be + i * 256 + lane * 4);
        u32x2 o = {pk2(v[r][i].x * rstd * a.x + b.x, v[r][i].y * rstd * a.y + b.y),
                   pk2(v[r][i].z * rstd * a.z + b.z, v[r][i].w * rstd * a.w + b.w)};
        *(u32x2*)(hn + (size_t)row * 1024 + i * 256 + lane * 4) = o;
      }
    }
  }
}

constexpr int PNT = 4;
template <int HW>
DI void pool_windows(const float* __restrict__ X, const float* __restrict__ rstd, int base, int l, int L, int c, float4 (&sout)[PNT]) {
  constexpr int NR = 2 * HW + PNT - 1;
  float4 v[NR];
#pragma unroll
  for (int i = 0; i < NR; ++i) {
    const int q = l - HW + i;
    const bool ok = q >= 0 && q < L;
    const int qq = ok ? q : l;
    const float r = ok ? rstd[base + qq] : 0.f;
    const float4 x = *(const float4*)(X + (size_t)(base + qq) * 1024 + c);
    v[i] = float4{x.x * r, x.y * r, x.z * r, x.w * r};
  }
  float4 s = {0.f, 0.f, 0.f, 0.f};
#pragma unroll
  for (int i = 0; i < 2 * HW; ++i) { s.x += v[i].x; s.y += v[i].y; s.z += v[i].z; s.w += v[i].w; }
  sout[0] = s;
#pragma unroll
  for (int k = 1; k < PNT; ++k) {
    s.x += v[k - 1 + 2 * HW].x - v[k - 1].x; s.y += v[k - 1 + 2 * HW].y - v[k - 1].y;
    s.z += v[k - 1 + 2 * HW].z - v[k - 1].z; s.w += v[k - 1 + 2 * HW].w - v[k - 1].w;
    sout[k] = s;
  }
}
DI void phase_pool_z(PP p) {
  const int tid = opaque_tid();
  const float* X = (const float*)(p->ws + OFF_X);
  const float* rstd = (const float*)(p->ws + OFF_RSTD);
  const float* modf = (const float*)(p->ws + OFF_MODF);
  bf16_t* Z = (bf16_t*)(p->ws + OFF_HN);
  const int total = (T_ALL / PNT) * 256;
  for (int idx = blockIdx.x * NTHREADS + tid; idx < total; idx += gridDim.x * NTHREADS) {
    const int tok = (idx >> 8) * PNT, c = (idx & 255) * 4;
    const int grp = c >> 8, hw = 1 << grp;
    int base, l, L;
    if (tok < 4096) { base = tok & ~255; l = tok & 255; L = 256; }
    else { int t2 = tok - 4096; base = 4096 + (t2 & ~2047); l = t2 & 2047; L = 2048; }
    float4 sw[PNT];
    if (grp == 0) pool_windows<1>(X, rstd, base, l, L, c, sw);
    else if (grp == 1) pool_windows<2>(X, rstd, base, l, L, c, sw);
    else if (grp == 2) pool_windows<4>(X, rstd, base, l, L, c, sw);
    else pool_windows<8>(X, rstd, base, l, L, c, sw);
    const float4 a = *(const float4*)(modf + (size_t)((1 * 5 + mod_row(tok)) * 6 + 0) * 1024 + c);
#pragma unroll
    for (int k = 0; k < PNT; ++k) {
      const int lk = l + k;
      const int lo = max(lk - hw, 0), hi = min(lk + hw, L);
      const float inv = 1.f / (float)(hi - lo);
      const float r0 = rstd[tok + k];
      const float4 v0 = *(const float4*)(X + (size_t)(tok + k) * 1024 + c);
      const float4 s = sw[k];
      u32x2 o = {pk2(a.x * (s.x * inv - v0.x * r0), a.y * (s.y * inv - v0.y * r0)),
                 pk2(a.z * (s.z * inv - v0.z * r0), a.w * (s.w * inv - v0.w * r0))};
      *(u32x2*)(Z + (size_t)(tok + k) * 1024 + c) = o;
    }
  }
}

#define LAS __attribute__((address_space(3)))
constexpr int BM = 256, BK = 64, HALF = 128, HTB = HALF * BK * 2, NXCD = 8, WGM = 8;
DI int lds_byte(int r, int c) {
  const int st = (r >> 4) * 2 + (c >> 5), rr = r & 15, cc = c & 31, ob = rr * 64 + cc * 2;
  return st * 1024 + (ob ^ (((ob >> 9) & 1) << 5));
}
DI void stage_rc(int b, int& R, int& C) {
  const int st = b / 1024, sb = b % 1024, swz = sb ^ (((sb >> 9) & 1) << 5);
  R = (st >> 1) * 16 + swz / 64; C = (st & 1) * 32 + (swz % 64) / 2;
}
struct Unit { int pm, pn; };
DI bool unit_next(int i, int nM, int nN, int G, int c, Unit& u) {
  const int nwg = nM * nN;
  const long L = (long)i * G + c; if (L >= nwg) return false;
  int wgid = (int)L;
  { const int q = nwg / NXCD, r = nwg % NXCD, xcd = wgid % NXCD, off = wgid / NXCD;
    wgid = (xcd < r ? xcd * (q + 1) : r * (q + 1) + (xcd - r) * q) + off; }
  const int nig = WGM * nN, gid = wgid / nig, fm = gid * WGM, gsz = (nM - fm) < WGM ? (nM - fm) : WGM;
  u.pm = fm + ((wgid % nig) % gsz); u.pn = (wgid % nig) / gsz; return true;
}

enum { EPI_INPROJ = 0, EPI_GLU, EPI_OUTPROJ, EPI_FF1, EPI_FF2, EPI_POOL };

struct GemmDesc {
  const bf16_t* W; int ldw;
  const bf16_t* Act; int lda;
  int K, nN;
  int act_pn_step;
  int a_tstep;
  int a_kstep;
  int kind, layer;
};

DI void gemm_epilogue(PP p, const GemmDesc& d, const f32x4 (&acc)[2][2][4][2], const Unit& u, int wr, int wc, int fr, int fq) {
  const int m0 = u.pm * 256, n0 = u.pn * 256;
  const int tokb = m0 + wr * 64 + fr;
  const int nnb = n0 + wc * 32 + fq * 4;
  const float* modf = (const float*)(p->ws + OFF_MODF);
  switch (d.kind) {
    case EPI_INPROJ: {
      const int region = u.pn >> 1;
      const bool is_lat = m0 >= 4096;
      bf16_t* Qb = (bf16_t*)(p->ws + OFF_Q);
      bf16_t* Kb = (bf16_t*)(p->ws + OFF_K);
      bf16_t* Vf = (bf16_t*)(p->ws + OFF_V);
      float* U = (float*)(p->ws + OFF_U);
      float inv[4];
#pragma unroll
      for (int j = 0; j < 4; ++j) inv[j] = exp2f(-(float)(fq * 4 + j) * 0.8304820237218406f);
#pragma unroll
      for (int ai = 0; ai < 2; ++ai)
#pragma unroll
      for (int m = 0; m < 4; ++m) {
        const int tok = tokb + ai * 128 + m * 16;
        const int lt = (tok - 4096) & 2047;
        const float pos = (wc & 1) ? (float)(lt & 63) : (float)(lt >> 6);
        float cs[4], sn[4];
        if (region < 2 && is_lat) {
#pragma unroll
          for (int j = 0; j < 4; ++j) { float ang = pos * inv[j]; cs[j] = __cosf(ang); sn[j] = __sinf(ang); }
        }
#pragma unroll
        for (int bj = 0; bj < 2; ++bj) {
          f32x4 v[2] = {acc[ai][bj][m][0], acc[ai][bj][m][1]};
          if (region < 2 && is_lat) {
            const f32x4 x1 = v[0], x2 = v[1];
#pragma unroll
            for (int j = 0; j < 4; ++j) { v[0][j] = x1[j] * cs[j] - x2[j] * sn[j]; v[1][j] = x2[j] * cs[j] + x1[j] * sn[j]; }
          }
#pragma unroll
          for (int n = 0; n < 2; ++n) {
            const int nn = nnb + bj * 128 + n * 16;
            const f32x4 vv = v[n];
            if (region == 0) {
              u32x2 o = {pk2(vv[0], vv[1]), pk2(vv[2], vv[3])};
              *(u32x2*)(Qb + (size_t)tok * 512 + nn) = o;
            } else if (region == 1) {
              u32x2 o = {pk2(vv[0], vv[1]), pk2(vv[2], vv[3])};
              {
                const int c = nn - 512, h = c >> 7, mm = (c >> 6) & 1, dd = c & 63;
                int base, l, nkt;
                if (!is_lat) { base = tok & ~255; l = tok & 255; nkt = 8; }
                else { int t2 = tok - 4096; base = 4096 + (t2 >> 11) * 2560; l = t2 & 2047; nkt = 80; }
                *(u32x2*)(Kb + kf_off(base, nkt, h, mm, l >> 5, dd >> 4, 32 * ((dd >> 3) & 1) + (l & 31)) + (dd & 7)) = o;
              }
              if (!is_lat) *(f32x4*)(p->out + OUT_K + (size_t)tok * 512 + (nn - 512)) = vv;
            } else if (region == 2) {
              const int c = nn - 1024, h = c >> 7, dd0 = c & 127;
              int base, l, nkt;
              if (!is_lat) { base = tok & ~255; l = tok & 255; nkt = 8; }
              else { int t2 = tok - 4096; base = 4096 + (t2 >> 11) * 2560; l = t2 & 2047; nkt = 80; }
              const int kt = l >> 5, kk = l & 31, s = kk >> 4, j8 = 4 * ((kk >> 3) & 1) + (kk & 3), hh = (kk >> 2) & 1;
#pragma unroll
              for (int jj = 0; jj < 4; ++jj) {
                int dd = dd0 + jj;
                Vf[vf_off(base, nkt, h, kt, dd >> 5, s, 32 * hh + (dd & 31)) + j8] = f2bf(vv[jj]);
              }
              if (!is_lat) *(f32x4*)(p->out + OUT_V + (size_t)tok * 512 + c) = vv;
            } else {
              *(f32x4*)(U + (size_t)tok * 512 + (nn - 1536)) = vv;
            }
          }
        }
      }
    } break;
    case EPI_GLU: {
      const bf16_t* G = (const bf16_t*)(p->ws + OFF_GS5);
      bf16_t* cat = (bf16_t*)(p->ws + OFF_CAT);
#pragma unroll
      for (int ai = 0; ai < 2; ++ai)
#pragma unroll
      for (int bj = 0; bj < 2; ++bj)
#pragma unroll
      for (int m = 0; m < 4; ++m)
#pragma unroll
      for (int n = 0; n < 2; ++n) {
        const int tok = tokb + ai * 128 + m * 16, nn = nnb + bj * 128 + n * 16;
        const f32x4 v = acc[ai][bj][m][n];
        u32x2 gi = *(const u32x2*)(G + (size_t)tok * 512 + nn);
        float g0 = __uint_as_float(gi[0] << 16), g1 = __uint_as_float(gi[0] & 0xffff0000u);
        float g2 = __uint_as_float(gi[1] << 16), g3 = __uint_as_float(gi[1] & 0xffff0000u);
        u32x2 o = {pk2(g0 / (1.f + __expf(-v[0])), g1 / (1.f + __expf(-v[1]))),
                   pk2(g2 / (1.f + __expf(-v[2])), g3 / (1.f + __expf(-v[3])))};
        *(u32x2*)(cat + (size_t)tok * 1024 + 512 + nn) = o;
      }
    } break;
    case EPI_OUTPROJ: case EPI_FF2: case EPI_POOL: {
      float* X = (float*)(p->ws + OFF_X);
      const int jg = d.kind == EPI_FF2 ? 5 : 2;
      const float* gate = modf + (size_t)((d.layer * 5 + mod_row(m0)) * 6 + jg) * 1024;
#pragma unroll
      for (int ai = 0; ai < 2; ++ai)
#pragma unroll
      for (int bj = 0; bj < 2; ++bj)
#pragma unroll
      for (int m = 0; m < 4; ++m)
#pragma unroll
      for (int n = 0; n < 2; ++n) {
        const int tok = tokb + ai * 128 + m * 16, nn = nnb + bj * 128 + n * 16;
        f32x4 v = acc[ai][bj][m][n];
        f32x4 g = *(const f32x4*)(gate + nn);
        f32x4 xin;
        if (d.kind == EPI_OUTPROJ) {
          const float* xs = tok < 4096 ? p->x_prompt + (size_t)tok * 1024 : p->x_sample + (size_t)(tok - 4096) * 1024;
          xin = *(const f32x4*)(xs + nn);
        } else {
          xin = *(const f32x4*)(X + (size_t)tok * 1024 + nn);
        }
        if (d.kind == EPI_POOL) { f32x4 ps = *(const f32x4*)(p->pool_scale + nn); v = v * ps; }
        *(f32x4*)(X + (size_t)tok * 1024 + nn) = xin + g * v;
      }
    } break;
    case EPI_FF1: {
      bf16_t* H = (bf16_t*)(p->ws + OFF_H);
#pragma unroll
      for (int ai = 0; ai < 2; ++ai)
#pragma unroll
      for (int bj = 0; bj < 2; ++bj)
#pragma unroll
      for (int m = 0; m < 4; ++m)
#pragma unroll
      for (int n = 0; n < 2; ++n) {
        const int tok = tokb + ai * 128 + m * 16, nn = nnb + bj * 128 + n * 16;
        f32x4 v = acc[ai][bj][m][n];
        float r0 = fmaxf(v[0], 0.f), r1 = fmaxf(v[1], 0.f), r2 = fmaxf(v[2], 0.f), r3 = fmaxf(v[3], 0.f);
        u32x2 o = {pk2(r0 * r0, r1 * r1), pk2(r2 * r2, r3 * r3)};
        *(u32x2*)(H + ((size_t)((tok >> 8) * 64 + (nn >> 6)) * 256 + (tok & 255)) * 64 + (nn & 63)) = o;
      }
    } break;
  }
}

DI void gemm_phase(PP p, const GemmDesc& d) {
  const int tid = opaque_tid();
  LAS unsigned char* lds = (LAS unsigned char*)g_smem;
  const int wid = __builtin_amdgcn_readfirstlane(tid >> 6), lane = tid & 63, wr = wid >> 2, wc = wid & 3, fr = lane & 15, fq = lane >> 4;
  const int K = d.K, nt = K / BK;
  const int nM = 48, nN = d.nN, G = gridDim.x, cblk = blockIdx.x;
  unsigned voffA[2], voffB[2];
#pragma unroll
  for (int i = 0; i < 2; ++i) { int R, C; stage_rc(tid * 16 + i * 8192, R, C);
    voffA[i] = (unsigned)(R * d.lda + C) * 2u; voffB[i] = (unsigned)(R * d.ldw + C) * 2u; }
  const size_t kstep = (size_t)(BK * 2);
  const size_t kstepA = (size_t)d.a_kstep;
  const size_t hstepA = (size_t)HALF * d.lda * 2, hstepB = (size_t)HALF * d.ldw * 2;
  const size_t tstepA = d.a_tstep ? (size_t)d.a_tstep : 2 * hstepA, tstepB = 2 * hstepB;
  const unsigned ldsw = (unsigned)wid * 1024u;
  const int aoff = lds_byte(wr * 64 + fr, fq * 8), boff = lds_byte(wc * 32 + fr, fq * 8);
#define PG8_SA(b, h) (((b) * 2 + (h)) * HTB)
#define PG8_SB(b, h) ((4 + (b) * 2 + (h)) * HTB)
#define PG8_STAGE(bufoff, gbase, voff) do { _Pragma("unroll") for (int _i = 0; _i < 2; ++_i) \
    __builtin_amdgcn_global_load_lds((const unsigned*)((const char*)(gbase) + (voff)[_i]), (LAS unsigned*)(lds + (bufoff) + ldsw + _i * 8192), 16, 0, 0); } while (0)
#define PG8_LDA(dst, b, h) do { _Pragma("unroll") for (int m = 0; m < 4; ++m) _Pragma("unroll") for (int k = 0; k < 2; ++k) dst[m][k] = *(const LAS bf16x8*)(lds + PG8_SA(b, h) + aoff + m * 2048 + k * 1024); } while (0)
#define PG8_LDB(dst, b, h) do { _Pragma("unroll") for (int n = 0; n < 2; ++n) _Pragma("unroll") for (int k = 0; k < 2; ++k) dst[n][k] = *(const LAS bf16x8*)(lds + PG8_SB(b, h) + boff + n * 2048 + k * 1024); } while (0)
#define PG8_MMA(ai, bj, At, Bt) do { __builtin_amdgcn_s_setprio(1); _Pragma("unroll") for (int m = 0; m < 4; ++m) _Pragma("unroll") for (int n = 0; n < 2; ++n) _Pragma("unroll") for (int k = 0; k < 2; ++k) \
    acc[ai][bj][m][n] = __builtin_amdgcn_mfma_f32_16x16x32_bf16(Bt[n][k], At[m][k], acc[ai][bj][m][n], 0, 0, 0); __builtin_amdgcn_s_setprio(0); } while (0)
#define PG8_WAIT_V(n) asm volatile("s_waitcnt vmcnt(" #n ")" ::: "memory")
#define PG8_WAIT_L(n) asm volatile("s_waitcnt lgkmcnt(" #n ")" ::: "memory")
#define PG8_BAR __builtin_amdgcn_s_barrier()
#define PG8_SCHED __builtin_amdgcn_sched_barrier(0)
  Unit cur, nxt; int ui = 0;
  if (!unit_next(0, nM, nN, G, cblk, cur)) return;
  f32x4 acc[2][2][4][2];
#pragma unroll
  for (int a = 0; a < 2; ++a)
#pragma unroll
    for (int b = 0; b < 2; ++b)
#pragma unroll
      for (int m = 0; m < 4; ++m)
#pragma unroll
        for (int n = 0; n < 2; ++n) acc[a][b][m][n] = (f32x4){0.f, 0.f, 0.f, 0.f};
  bf16x8 At[4][2], B0[2][2], B1[2][2];
  const char* cA = (const char*)d.Act + (size_t)cur.pm * tstepA + (size_t)cur.pn * d.act_pn_step;
  const char* cB = (const char*)d.W + (size_t)cur.pn * tstepB;
  PG8_STAGE(PG8_SB(0, 0), cB, voffB); PG8_STAGE(PG8_SA(0, 0), cA, voffA); PG8_STAGE(PG8_SB(0, 1), cB + hstepB, voffB); PG8_STAGE(PG8_SA(0, 1), cA + hstepA, voffA);
  if (wr == 1) PG8_BAR;
  PG8_WAIT_V(4); PG8_BAR;
  PG8_STAGE(PG8_SB(1, 0), cB + kstep, voffB); PG8_STAGE(PG8_SA(1, 0), cA + kstepA, voffA); PG8_STAGE(PG8_SB(1, 1), cB + hstepB + kstep, voffB);
  PG8_WAIT_V(6); PG8_BAR;
  for (;;) {
    const bool has_next = unit_next(ui + 1, nM, nN, G, cblk, nxt);
    const char* nA = has_next ? (const char*)d.Act + (size_t)nxt.pm * tstepA + (size_t)nxt.pn * d.act_pn_step : cA;
    const char* nB = has_next ? (const char*)d.W + (size_t)nxt.pn * tstepB : cB;
    for (int t = 0; t < nt; t += 2) {
      const bool last = (t == nt - 2);
      const char* a1 = cA + (size_t)(t + 1) * kstepA;
      const char* a2 = last ? nA : cA + (size_t)(t + 2) * kstepA; const char* b2 = last ? nB : cB + (size_t)(t + 2) * kstep;
      const char* a3 = a2 + kstepA; const char* b3 = b2 + kstep;
      PG8_LDB(B0, 0, 0); PG8_SCHED; PG8_LDA(At, 0, 0); PG8_STAGE(PG8_SA(1, 1), a1 + hstepA, voffA);
      PG8_WAIT_L(8); PG8_BAR; PG8_WAIT_L(0); PG8_MMA(0, 0, At, B0); PG8_BAR; PG8_SCHED;
      PG8_LDB(B1, 0, 1); PG8_STAGE(PG8_SB(0, 0), b2, voffB);
      PG8_BAR; PG8_WAIT_L(0); PG8_MMA(0, 1, At, B1); PG8_BAR;
      PG8_LDA(At, 0, 1); PG8_STAGE(PG8_SA(0, 0), a2, voffA);
      PG8_BAR; PG8_WAIT_L(0); PG8_MMA(1, 0, At, B0); PG8_BAR; PG8_SCHED;
      PG8_STAGE(PG8_SB(0, 1), b2 + hstepB, voffB);
      PG8_WAIT_V(6); PG8_BAR; PG8_MMA(1, 1, At, B1); PG8_BAR;
      PG8_LDB(B0, 1, 0); PG8_SCHED; PG8_LDA(At, 1, 0); PG8_STAGE(PG8_SA(0, 1), a2 + hstepA, voffA);
      PG8_WAIT_L(8); PG8_BAR; PG8_WAIT_L(0); PG8_MMA(0, 0, At, B0); PG8_BAR; PG8_SCHED;
      PG8_LDB(B1, 1, 1); PG8_STAGE(PG8_SB(1, 0), b3, voffB);
      PG8_BAR; PG8_WAIT_L(0); PG8_MMA(0, 1, At, B1); PG8_BAR;
      PG8_LDA(At, 1, 1); PG8_STAGE(PG8_SA(1, 0), a3, voffA);
      PG8_BAR; PG8_WAIT_L(0); PG8_MMA(1, 0, At, B0); PG8_BAR; PG8_SCHED;
      PG8_STAGE(PG8_SB(1, 1), b3 + hstepB, voffB);
      PG8_WAIT_V(6); PG8_BAR; PG8_MMA(1, 1, At, B1); PG8_BAR;
    }
    gemm_epilogue(p, d, acc, cur, wr, wc, fr, fq);
    if (!has_next) break;
#pragma unroll
    for (int a = 0; a < 2; ++a)
#pragma unroll
      for (int b = 0; b < 2; ++b)
#pragma unroll
        for (int m = 0; m < 4; ++m)
#pragma unroll
          for (int n = 0; n < 2; ++n) acc[a][b][m][n] = (f32x4){0.f, 0.f, 0.f, 0.f};
    cur = nxt; cA = nA; cB = nB; ++ui;
  }
  PG8_WAIT_V(0);
  if (wr == 0) PG8_BAR;
  PG8_BAR;
}

#define MFMA32(a, b, c) __builtin_amdgcn_mfma_f32_32x32x16_bf16((a), (b), (c), 0, 0, 0)
#define MFMA16(a, b, c) __builtin_amdgcn_mfma_f32_16x16x32_bf16((a), (b), (c), 0, 0, 0)

struct AttnGeom { const bf16_t* qp; const bf16_t* kp; const bf16_t* vp; int qrow; int h; int nkt; };

DI AttnGeom attn_geom(PP p, bool is_lat, int b, int h, int qt, int lane) {
  const int r32 = lane & 31, hh = lane >> 5;
  const bf16_t* Qb = (const bf16_t*)(p->ws + OFF_Q);
  const bf16_t* Kb = (const bf16_t*)(p->ws + OFF_K);
  const bf16_t* Vf = (const bf16_t*)(p->ws + OFF_V);
  int tokbase, kvbase, nkt;
  if (!is_lat) { tokbase = b * 256; kvbase = b * 256; nkt = 8; }
  else { tokbase = 4096 + b * 2048; kvbase = 4096 + b * 2560; nkt = 80; }
  AttnGeom g;
  g.qrow = tokbase + 32 * qt + r32; g.h = h;
  g.qp = Qb + (size_t)g.qrow * 512 + h * 128 + 8 * hh;
  g.kp = Kb + kf_off(kvbase, nkt, h, 0, 0, 0, lane); g.nkt = nkt;
  g.vp = Vf + vf_off(kvbase, nkt, h, 0, 0, 0, lane);
  return g;
}
#define ATT_CS (0.125f * 1.4426950408889634f)
#define EXP2(x) __builtin_amdgcn_exp2f(x)
DI void attn_loadk(bf16x8 (&kc)[2][4], const bf16_t* kq, int nkt) {
#pragma unroll
  for (int m = 0; m < 2; ++m)
#pragma unroll
    for (int s = 0; s < 4; ++s) kc[m][s] = *(const bf16x8*)(kq + (size_t)m * nkt * 2048 + s * 512);
}
DI void attn_pass1(const AttnGeom& g, const bf16x8 (&Qf)[2][4], int kt0, int kt1, float (&mx)[2], float (&ls)[2]) {
  const float cs = ATT_CS;
  bf16x8 kc[2][4];
  attn_loadk(kc, g.kp + (size_t)kt0 * 2048, g.nkt);
#pragma unroll 1
  for (int kt = kt0; kt < kt1; ++kt) {
    f32x16 S[2];
#pragma unroll
    for (int m = 0; m < 2; ++m) {
#pragma unroll
      for (int i = 0; i < 16; ++i) S[m][i] = 0.f;
#pragma unroll
      for (int s = 0; s < 4; ++s) S[m] = MFMA32(kc[m][s], Qf[m][s], S[m]);
    }
    const int ktn = kt + 1 < kt1 ? kt + 1 : kt;
    attn_loadk(kc, g.kp + (size_t)ktn * 2048, g.nkt);
#pragma unroll
    for (int m = 0; m < 2; ++m) {
      float tm = S[m][0];
#pragma unroll
      for (int i = 1; i < 16; ++i) tm = fmaxf(tm, S[m][i]);
      float mn = fmaxf(mx[m], tm);
      float acc = ls[m] * EXP2((mx[m] - mn) * cs);
      float nb = -mn * cs;
#pragma unroll
      for (int i = 0; i < 16; ++i) acc += EXP2(fmaf(S[m][i], cs, nb));
      ls[m] = acc; mx[m] = mn;
    }
  }
}
DI void attn_pass2(const AttnGeom& g, const bf16x8 (&Qf)[2][4], int kt0, int kt1, const float (&nbias)[2], const float (&pscale)[2],
                   f32x16 (&O)[4]) {
  const float cs = ATT_CS;
  bf16x8 kc[2][4];
  attn_loadk(kc, g.kp + (size_t)kt0 * 2048, g.nkt);
#pragma unroll 1
  for (int kt = kt0; kt < kt1; ++kt) {
    const bf16_t* vq = g.vp + (size_t)kt * 4096;
    bf16x8 vf[8];
#pragma unroll
    for (int i = 0; i < 8; ++i) vf[i] = *(const bf16x8*)(vq + i * 512);
    f32x16 S0, S1;
#pragma unroll
    for (int i = 0; i < 16; ++i) { S0[i] = 0.f; S1[i] = 0.f; }
#pragma unroll
    for (int s = 0; s < 4; ++s) { S0 = MFMA32(kc[0][s], Qf[0][s], S0); S1 = MFMA32(kc[1][s], Qf[1][s], S1); }
    const int ktn = kt + 1 < kt1 ? kt + 1 : kt;
    attn_loadk(kc, g.kp + (size_t)ktn * 2048, g.nkt);
    float w[16];
#pragma unroll
    for (int i = 0; i < 16; ++i)
      w[i] = EXP2(fmaf(S0[i], cs, nbias[0])) * pscale[0] - EXP2(fmaf(S1[i], cs, nbias[1])) * pscale[1];
#pragma unroll
    for (int s = 0; s < 2; ++s) {
      u32x4 pw = {pk2(w[8 * s], w[8 * s + 1]), pk2(w[8 * s + 2], w[8 * s + 3]),
                  pk2(w[8 * s + 4], w[8 * s + 5]), pk2(w[8 * s + 6], w[8 * s + 7])};
      bf16x8 wf = __builtin_bit_cast(bf16x8, pw);
#pragma unroll
      for (int dt = 0; dt < 4; ++dt) O[dt] = MFMA32(vf[dt * 2 + s], wf, O[dt]);
    }
  }
}
DI void attn_finish(PP p, const AttnGeom& g, const f32x16 (&O)[4], int lane) {
  const int hh = lane >> 5;
  bf16_t* cat = (bf16_t*)(p->ws + OFF_CAT);
  float ss = 0.f;
#pragma unroll
  for (int dt = 0; dt < 4; ++dt)
#pragma unroll
    for (int i = 0; i < 16; ++i) ss += O[dt][i] * O[dt][i];
  ss += __shfl_xor(ss, 32);
  const float rstd = rsqrtf(ss * (1.f / 128.f) + 1e-6f) * 0.8f;
#pragma unroll
  for (int dt = 0; dt < 4; ++dt)
#pragma unroll
    for (int i4 = 0; i4 < 4; ++i4) {
      const int d0 = 32 * dt + 8 * i4 + 4 * hh;
      f32x4 gg = *(const f32x4*)(p->subln_g + d0);
      u32x2 o = {pk2(O[dt][4 * i4] * rstd * gg[0], O[dt][4 * i4 + 1] * rstd * gg[1]),
                 pk2(O[dt][4 * i4 + 2] * rstd * gg[2], O[dt][4 * i4 + 3] * rstd * gg[3])};
      *(u32x2*)(cat + (size_t)g.qrow * 1024 + g.h * 128 + d0) = o;
    }
}
DI void attn_loadq(const AttnGeom& g, bf16x8 (&Qf)[2][4]) {
#pragma unroll
  for (int m = 0; m < 2; ++m)
#pragma unroll
    for (int s = 0; s < 4; ++s) Qf[m][s] = *(const bf16x8*)(g.qp + m * 64 + 16 * s);
}

DI void attn_item_solo(PP p, int b, int h, int qt, float lam, const int tid) {
  const int lane = tid & 63;
  const AttnGeom g = attn_geom(p, false, b, h, qt, lane);
  bf16x8 Qf[2][4];
  attn_loadq(g, Qf);
  const float cs = ATT_CS;
  float mx[2] = {-1e30f, -1e30f}, ls[2] = {0.f, 0.f};
  attn_pass1(g, Qf, 0, 8, mx, ls);
  float nbias[2], pscale[2];
#pragma unroll
  for (int m = 0; m < 2; ++m) {
    float mo = __shfl_xor(mx[m], 32), lo = __shfl_xor(ls[m], 32);
    float M = fmaxf(mx[m], mo);
    float L = ls[m] * EXP2((mx[m] - M) * cs) + lo * EXP2((mo - M) * cs);
    nbias[m] = -M * cs;
    pscale[m] = (m == 0 ? 1.f : lam) / L;
  }
  f32x16 O[4];
#pragma unroll
  for (int dt = 0; dt < 4; ++dt)
#pragma unroll
    for (int i = 0; i < 16; ++i) O[dt][i] = 0.f;
  attn_pass2(g, Qf, 0, 8, nbias, pscale, O);
  attn_finish(p, g, O, lane);
}

#define ATT_STAGE 32768
#define ATT_WAITV(n) asm volatile("s_waitcnt vmcnt(" #n ")" ::: "memory")
#define ATT_BAR do { asm volatile("" ::: "memory"); __builtin_amdgcn_s_barrier(); asm volatile("" ::: "memory"); } while (0)
template <bool WITHV>
DI void attn_stage_issue(const bf16_t* kbh, const bf16_t* vbh, int t, int stage, int tid, LAS unsigned char* lds) {
  const int lane = tid & 63, wv = __builtin_amdgcn_readfirstlane(tid >> 6);
#pragma unroll
  for (int kh = 0; kh < 2; ++kh) {
    const int kt = kh * 40 + t;
    const bf16_t* ksrc = kbh + ((size_t)(((wv >> 2) * 80 + kt) * 4 + (wv & 3))) * 512 + lane * 8;
    __builtin_amdgcn_global_load_lds((const unsigned*)ksrc, (LAS unsigned*)(lds + stage * ATT_STAGE + kh * 16384 + wv * 1024), 16, 0, 0);
    if (WITHV) {
      const bf16_t* vsrc = vbh + (size_t)kt * 4096 + tid * 8;
      __builtin_amdgcn_global_load_lds((const unsigned*)vsrc, (LAS unsigned*)(lds + stage * ATT_STAGE + kh * 16384 + 8192 + wv * 1024), 16, 0, 0);
    }
  }
}

DI void attn_stage_issue2(const bf16_t* kbh, const bf16_t* vbh, int T, int stage, int tid, LAS unsigned char* lds) {
  const int lane = tid & 63, wv = __builtin_amdgcn_readfirstlane(tid >> 6);
#pragma unroll
  for (int j = 0; j < 2; ++j) {
    const int kt = 2 * T + j;
    const bf16_t* ksrc = kbh + ((size_t)(((wv >> 2) * 80 + kt) * 4 + (wv & 3))) * 512 + lane * 8;
    __builtin_amdgcn_global_load_lds((const unsigned*)ksrc, (LAS unsigned*)(lds + stage * ATT_STAGE + j * 16384 + wv * 1024), 16, 0, 0);
    const bf16_t* vsrc = vbh + (size_t)kt * 4096 + tid * 8;
    __builtin_amdgcn_global_load_lds((const unsigned*)vsrc, (LAS unsigned*)(lds + stage * ATT_STAGE + j * 16384 + 8192 + wv * 1024), 16, 0, 0);
  }
}

DI void attn_block(PP p, int base_item, float lam, const int tid) {
  LAS unsigned char* lds = (LAS unsigned char*)g_smem;
  const int lane = tid & 63, wid = __builtin_amdgcn_readfirstlane(tid >> 6), mp = wid & 1;
  const int item = base_item + (wid >> 1);
  const int b = item >> 8, h = (item >> 6) & 3;
  const AttnGeom g = attn_geom(p, true, b, h, item & 63, lane);
  const int kvbase = 4096 + b * 2560;
  const bf16_t* kbh = (const bf16_t*)(p->ws + OFF_K) + kf_off(kvbase, 80, h, 0, 0, 0, 0);
  const bf16_t* vbh = (const bf16_t*)(p->ws + OFF_V) + vf_off(kvbase, 80, h, 0, 0, 0, 0);
  float* odump = (float*)(g_smem + (wid >> 1) * 16384);
  bf16x8 Qf[4];
#pragma unroll
  for (int s = 0; s < 4; ++s) Qf[s] = *(const bf16x8*)(g.qp + mp * 64 + 16 * s);
  const float cs = ATT_CS;
  const float TAU = 8.0f / ATT_CS;
  const unsigned rdK = mp * 4096 + lane * 16, rdV = 8192 + lane * 16;
  float mrun = -1e30f, lsum = 0.f;
  f32x16 O[4];
#pragma unroll
  for (int dt = 0; dt < 4; ++dt)
#pragma unroll
    for (int i = 0; i < 16; ++i) O[dt][i] = 0.f;
#define MS_QK(SLOTP, DST) do { _Pragma("unroll") for (int i_ = 0; i_ < 16; ++i_) DST[i_] = 0.f; \
    _Pragma("unroll") for (int s_ = 0; s_ < 4; ++s_) DST = MFMA32(*(const LAS bf16x8*)((SLOTP) + rdK + s_ * 1024), Qf[s_], DST); } while (0)
#define MS_SOFTMAX(S) do { \
    float tm_ = S[0]; _Pragma("unroll") for (int i_ = 1; i_ < 16; ++i_) tm_ = fmaxf(tm_, S[i_]); \
    { auto sw_ = __builtin_amdgcn_permlane32_swap(__float_as_uint(tm_), __float_as_uint(tm_), false, false); tm_ = fmaxf(__uint_as_float(sw_[0]), __uint_as_float(sw_[1])); } \
    if (__any(tm_ > mrun + TAU)) { const float mn_ = fmaxf(mrun, tm_); const float al_ = EXP2((mrun - mn_) * cs); lsum *= al_; \
      _Pragma("unroll") for (int dt_ = 0; dt_ < 4; ++dt_) _Pragma("unroll") for (int i_ = 0; i_ < 16; ++i_) O[dt_][i_] *= al_; mrun = mn_; } \
    const float nb_ = -mrun * cs; float ac_ = 0.f; \
    _Pragma("unroll") for (int i_ = 0; i_ < 16; ++i_) { S[i_] = EXP2(fmaf(S[i_], cs, nb_)); ac_ += S[i_]; } \
    lsum += ac_; \
    _Pragma("unroll") for (int s_ = 0; s_ < 2; ++s_) { \
      u32x4 pw_ = {pk2(S[8 * s_], S[8 * s_ + 1]), pk2(S[8 * s_ + 2], S[8 * s_ + 3]), pk2(S[8 * s_ + 4], S[8 * s_ + 5]), pk2(S[8 * s_ + 6], S[8 * s_ + 7])}; \
      P[s_] = __builtin_bit_cast(bf16x8, pw_); } } while (0)
#define MS_PV(SLOTP) do { _Pragma("unroll") for (int s_ = 0; s_ < 2; ++s_) _Pragma("unroll") for (int dt_ = 0; dt_ < 4; ++dt_) \
    O[dt_] = MFMA32(*(const LAS bf16x8*)((SLOTP) + rdV + (dt_ * 2 + s_) * 1024), P[s_], O[dt_]); } while (0)
  ATT_BAR;
  attn_stage_issue2(kbh, vbh, 0, 0, tid, lds);
  attn_stage_issue2(kbh, vbh, 1, 1, tid, lds);
  attn_stage_issue2(kbh, vbh, 2, 2, tid, lds);
  ATT_WAITV(8);
  ATT_BAR;
  f32x16 Sa, Sb;
  MS_QK(lds, Sa);
#pragma unroll 1
  for (int T = 0; T < 40; ++T) {
    const LAS unsigned char* stc = lds + (T & 3) * ATT_STAGE;
    const LAS unsigned char* stn = lds + ((T + 1) & 3) * ATT_STAGE;
    if (T + 1 < 40) {
      if (T + 2 < 40) ATT_WAITV(4); else ATT_WAITV(0);
      ATT_BAR;
      if (T + 3 < 40) attn_stage_issue2(kbh, vbh, T + 3, (T + 3) & 3, tid, lds);
    }
    bf16x8 P[2];
    MS_QK(stc + 16384, Sb);
    MS_SOFTMAX(Sa);
    MS_PV(stc);
    if (T + 1 < 40) MS_QK(stn, Sa);
    MS_SOFTMAX(Sb);
    MS_PV(stc + 16384);
  }
  { auto sw_ = __builtin_amdgcn_permlane32_swap(__float_as_uint(lsum), __float_as_uint(lsum), false, false); lsum = __uint_as_float(sw_[0]) + __uint_as_float(sw_[1]); }
  const float sc = (mp == 0 ? 1.f : lam) / lsum;
  asm volatile("s_waitcnt lgkmcnt(0)" ::: "memory");
  ATT_BAR;
  if (mp) {
#pragma unroll
    for (int dt = 0; dt < 4; ++dt)
#pragma unroll
      for (int i = 0; i < 16; ++i) odump[(dt * 16 + i) * 64 + lane] = O[dt][i] * sc;
  }
  asm volatile("s_waitcnt lgkmcnt(0)" ::: "memory");
  ATT_BAR;
  if (!mp) {
#pragma unroll
    for (int dt = 0; dt < 4; ++dt)
#pragma unroll
      for (int i = 0; i < 16; ++i) O[dt][i] = O[dt][i] * sc - odump[(dt * 16 + i) * 64 + lane];
    attn_finish(p, g, O, lane);
  }
  asm volatile("s_waitcnt lgkmcnt(0)" ::: "memory");
  ATT_BAR;
}

constexpr int S5_BU_STRIDE = 132;
constexpr int S5_H_STRIDE = 136;
constexpr int S5_ROWS = 64;
constexpr int S5_WAVE_LDS = S5_ROWS * S5_H_STRIDE * 2;

DI float gelu_tanh(float x) {
  float z = 0.7978845608028654f * (x + 0.044715f * x * x * x);
  float e = __expf(2.f * z);
  float t = 1.f - 2.f / (e + 1.f);
  return 0.5f * x * (1.f + t);
}

template <bool FULL>
DI void s5_task(PP p, int gc, int g, const int tid) {
  const int lane = tid & 63, wid = tid >> 6, fr = lane & 15, fq = lane >> 4;
  bf16_t* Hs = (bf16_t*)(g_smem + wid * S5_WAVE_LDS);
  const float* U = (const float*)(p->ws + OFF_U);
  float* E = (float*)(p->ws + OFF_E);
  const bool is_lat = gc >= 64;
  int seqb, c, nc, gcbase;
  if (!is_lat) { seqb = gc >> 2; c = gc & 3; nc = 4; gcbase = gc & ~3; }
  else { seqb = (gc - 64) >> 5; c = (gc - 64) & 31; nc = 32; gcbase = 64 + ((gc - 64) & ~31); }
  const int t0 = gc * 64;
  f32x4 yacc[4];
#pragma unroll
  for (int i = 0; i < 4; ++i) yacc[i] = f32x4{0.f, 0.f, 0.f, 0.f};
  u32x4 ufa[4];
#pragma unroll
  for (int sc = 0; sc < 4; ++sc) {
    ufa[sc] = u32x4{0, 0, 0, 0};
    if (fq < 2) {
      const float* up = U + (size_t)(t0 + 16 * sc + fr) * 512 + 16 * g + 8 * fq;
      float4 v0 = *(const float4*)up, v1 = *(const float4*)(up + 4);
      ufa[sc] = u32x4{pk2(v0.x, v0.y), pk2(v0.z, v0.w), pk2(v1.x, v1.y), pk2(v1.z, v1.w)};
    }
  }

  float4 av2[2]; bf16x8 Bf2[2][8]; bf16x8 Cf2[2][4];
#pragma unroll
  for (int d2 = 0; d2 < 2; ++d2) {
    av2[d2] = ((const float4*)(p->ws + OFF_S5TA))[(d2 * 32 + g) * 64 + lane];
    const u32x4* tb = (const u32x4*)(p->ws + OFF_S5TB) + (size_t)((d2 * 32 + g) * 8) * 64 + lane;
#pragma unroll
    for (int nt = 0; nt < 8; ++nt) Bf2[d2][nt] = __builtin_bit_cast(bf16x8, tb[nt * 64]);
    if (FULL) {
      const u32x4* tc = (const u32x4*)(p->ws + OFF_S5TC) + (size_t)((d2 * 32 + g) * 4) * 64 + lane;
#pragma unroll
      for (int ks = 0; ks < 4; ++ks) Cf2[d2][ks] = __builtin_bit_cast(bf16x8, tc[ks * 64]);
    }
  }
#pragma unroll
  for (int dr = 0; dr < 2; ++dr) {
    const float4 av = av2[dr];
    const float a_re = av.x, a_im = av.y;
    float hre = 0.f, him = 0.f;
    if (FULL) {
      const float A64r = av.z, A64i = av.w;
      if (is_lat) {
        const float* h0 = p->state_s5 + ((size_t)((seqb * 2 + dr) * 32 + g) * 64 + lane) * 2;
        hre = h0[0]; him = h0[1];
      }
      {
        const int cnt = dr == 0 ? c : nc - 1 - c;
        const int j0 = dr == 0 ? gcbase : gcbase + nc - 1, js = dr == 0 ? 1 : -1;
        const float2* Eb = (const float2*)E + ((size_t)g * 2 + dr) * 64 + lane;
        for (int q0 = 0; q0 < cnt; q0 += 16) {
          float2 ev[16];
#pragma unroll
          for (int q = 0; q < 16; ++q) {
            const int jj = q0 + q < cnt ? j0 + js * (q0 + q) : j0;
            ev[q] = Eb[(size_t)jj * (32 * 2 * 64)];
          }
#pragma unroll
          for (int q = 0; q < 16; ++q) {
            if (q0 + q < cnt) {
              float tr, ti; cmul(A64r, A64i, hre, him, tr, ti);
              hre = tr + ev[q].x; him = ti + ev[q].y;
            }
          }
        }
      }
    }
    const bf16x8 (&Bf)[8] = Bf2[dr];
    const bf16x8 (&Cf)[4] = Cf2[dr];
    bf16_t* BH = Hs;
    wave_lds_sync();
#pragma unroll
    for (int tile = 0; tile < 4; ++tile) {
      const bf16x8 ufr = __builtin_bit_cast(bf16x8, ufa[tile]);
#pragma unroll
      for (int nt = 0; nt < 8; ++nt) {
        f32x4 z = {0.f, 0.f, 0.f, 0.f};
        f32x4 d = MFMA16(Bf[nt], ufr, z);
        u32x2 o = {pk2(d[0], d[1]), pk2(d[2], d[3])};
        *(u32x2*)(BH + (16 * tile + fr) * S5_H_STRIDE + 16 * nt + 4 * fq) = o;
      }
    }
    wave_lds_sync();
#pragma unroll 1
    for (int hh = 0; hh < 4; ++hh) {
      const int tile = dr == 0 ? hh : 3 - hh;
      float bre[16], bim[16];
#pragma unroll
      for (int t = 0; t < 16; ++t) { bre[t] = bf2f(BH[(16 * tile + t) * S5_H_STRIDE + lane]); bim[t] = bf2f(BH[(16 * tile + t) * S5_H_STRIDE + 64 + lane]); }
      asm volatile("s_waitcnt lgkmcnt(0)" ::: "memory");
      __builtin_amdgcn_wave_barrier();
      if (dr == 1) {
#pragma unroll
        for (int t = 0; t < 8; ++t) { float x = bre[t]; bre[t] = bre[15 - t]; bre[15 - t] = x; x = bim[t]; bim[t] = bim[15 - t]; bim[15 - t] = x; }
      }
      const int tsgn = dr == 0 ? 1 : -1, tbase = 16 * tile + (dr == 0 ? 0 : 15);
#pragma unroll
      for (int tt = 0; tt < 16; ++tt) {
        const int t = tbase + tsgn * tt;
        const float nre = fmaf(-a_im, him, fmaf(a_re, hre, bre[tt]));
        const float nim = fmaf(a_im, hre, fmaf(a_re, him, bim[tt]));
        hre = nre; him = nim;
        if (FULL) { BH[t * S5_H_STRIDE + lane] = f2bf(nre); BH[t * S5_H_STRIDE + 64 + lane] = f2bf(nim); }
      }
      asm volatile("" ::: "memory");
    }
    if (FULL) {
      wave_lds_sync();
#pragma unroll
      for (int tile = 0; tile < 4; ++tile)
#pragma unroll
        for (int ks = 0; ks < 4; ++ks) {
          bf16x8 hf = *(const bf16x8*)(BH + (16 * tile + fr) * S5_H_STRIDE + 32 * ks + 8 * fq);
          yacc[tile] = MFMA16(Cf[ks], hf, yacc[tile]);
        }
    }
    if (!FULL) {
      float* e = E + ((size_t)((gc * 32 + g) * 2 + dr) * 64 + lane) * 2;
      e[0] = hre; e[1] = him;
    } else if (!is_lat) {
      if ((dr == 0 && c == nc - 1) || (dr == 1 && c == 0)) {
        float* o = p->out + OUT_S + ((size_t)((seqb * 2 + dr) * 32 + g) * 64 + lane) * 2;
        o[0] = hre; o[1] = him;
      }
    }
  }
  if (FULL) {
    bf16_t* G = (bf16_t*)(p->ws + OFF_GS5);
    const f32x4 dsk = *(const f32x4*)(p->s5_d + 16 * g + 4 * fq);
#pragma unroll
    for (int sc = 0; sc < 4; ++sc) {
      const int tok = t0 + 16 * sc + fr;
      const f32x4 u = *(const f32x4*)(U + (size_t)tok * 512 + 16 * g + 4 * fq);
      f32x4 y = yacc[sc] + dsk * u;
      u32x2 o = {pk2(gelu_tanh(y[0]), gelu_tanh(y[1])), pk2(gelu_tanh(y[2]), gelu_tanh(y[3]))};
      *(u32x2*)(G + (size_t)tok * 512 + 16 * g + 4 * fq) = o;
    }
  }
}

DI void phase_attn_s5a(PP p, int part) {
  const int tid = opaque_tid();
  const int lane = tid & 63, wid = tid >> 6;
  float v1 = p->dl_qk[lane] * p->dl_qk[64 + lane], v2 = p->dl_qk[128 + lane] * p->dl_qk[192 + lane];
  v1 = wave_sum(v1); v2 = wave_sum(v2);
  const float lam = __uint_as_float((unsigned)__builtin_amdgcn_readfirstlane((int)__float_as_uint(expf(v1) - expf(v2) + 0.2f)));
  if (part != 2)
  {
    const int G = gridDim.x;
    const int lb = (G & 7) == 0 ? (blockIdx.x & 7) * (G >> 3) + (blockIdx.x >> 3) : blockIdx.x;
    for (int base = lb * 4; base < 1024; base += G * 4) attn_block(p, base, lam, tid);
  }
  if (part == 1) return;
  {
    const int tid2 = opaque_tid();
    const int lane2 = tid2 & 63;
    volatile unsigned* ctr = (volatile unsigned*)(g_smem + LDS_ST_OFF + 32);
    if (tid2 == 0) *ctr = 0u;
    __syncthreads();
    for (;;) {
      unsigned k = 0;
      if (lane2 == 0) k = atomicAdd((unsigned*)ctr, 1u);
      k = (unsigned)__builtin_amdgcn_readfirstlane((int)k);
      const int j = blockIdx.x + (int)k * gridDim.x;
      if (j >= 512 + 6144) break;
      if (j < 512) attn_item_solo(p, j >> 5, (j >> 3) & 3, j & 7, lam, tid2);
      else { int tsk = j - 512; s5_task<false>(p, tsk >> 5, tsk & 31, tid2); }
    }
  }
}
DI void phase_s5c(PP p) {
  const int tid = opaque_tid();
  const int wid = tid >> 6;
  const int nW = gridDim.x * 8, gw = blockIdx.x * 8 + wid;
  for (int tsk = gw; tsk < 6144; tsk += nW) s5_task<true>(p, tsk >> 5, tsk & 31, tid);
}

#define XB_TMO      128
#define XB_XCNT(j)  (256  + 64 * (j))
#define XB_XSUB(j)  (1280 + 64 * (j))
#define XB_XGEN(j)  (2304 + 64 * (j))
#define XB_TOP      3328
#define XB_TOPGEN   3392
#define XCD_BAR_WORDS 3456
#define XB_SPIN_CAP (1u << 18)
#define XLAS __attribute__((address_space(3)))
DI unsigned xb_ld(unsigned* p)              { return __hip_atomic_load(p, __ATOMIC_RELAXED, __HIP_MEMORY_SCOPE_AGENT); }
DI unsigned xb_add(unsigned* p, unsigned v) { return __hip_atomic_fetch_add(p, v, __ATOMIC_RELAXED, __HIP_MEMORY_SCOPE_AGENT); }
DI unsigned xb_xcc_id() { return (unsigned)__builtin_amdgcn_s_getreg((3 << 11) | 20) & 0xFu; }
#define XB_SPIN(cond, bar) do { unsigned _sp = 0; while (cond) { __builtin_amdgcn_s_sleep(1); \
    if ((++_sp & 255u) == 0u) { if (xb_ld(&(bar)[XB_TMO])) break; if (_sp > XB_SPIN_CAP) { atomicAdd(&(bar)[XB_TMO], 1u); break; } } } } while (0)
struct XcdBarrier { unsigned* bar; unsigned x; volatile XLAS unsigned* st; };
DI XcdBarrier xcd_barrier_post(unsigned* bar, volatile XLAS unsigned* st) {
  XcdBarrier b; b.bar = bar; b.x = xb_xcc_id(); b.st = st;
  if (threadIdx.x == 0) (void)xb_add(&bar[XB_XCNT(b.x)], 1u);
  return b;
}
DI void xcd_barrier_complete(unsigned* bar, unsigned x, unsigned& nloc, unsigned& nx) {
  const unsigned G = gridDim.x * gridDim.y * gridDim.z;
  unsigned sum, cnt, mine, sp = 0u;
  for (;;) {
    sum = 0u; cnt = 0u; mine = 0u;
#pragma unroll
    for (unsigned j = 0; j < 16; ++j) { const unsigned c = xb_ld(&bar[XB_XCNT(j)]); sum += c; cnt += (c > 0u) ? 1u : 0u; mine = (j == x) ? c : mine; }
    if (sum == G) break;
    __builtin_amdgcn_s_sleep(1);
    if ((++sp & 255u) == 0u) { if (xb_ld(&bar[XB_TMO])) break; if (sp > XB_SPIN_CAP) { atomicAdd(&bar[XB_TMO], 1u); break; } }
  }
  nloc = mine > 0u ? mine : 1u; nx = cnt > 0u ? cnt : 1u;
}
DI void xcd_barrier(const XcdBarrier& b) {
  asm volatile("s_waitcnt vmcnt(0)" ::: "memory");
  __syncthreads();
  if (threadIdx.x == 0) {
    unsigned* bar = b.bar;
    __builtin_amdgcn_s_waitcnt(0);
    unsigned nloc = b.st[0], nx = b.st[1];
    if (nloc == 0u) { xcd_barrier_complete(bar, b.x, nloc, nx); b.st[0] = nloc; b.st[1] = nx; }
    const unsigned old = xb_add(&bar[XB_XSUB(b.x)], 1u);
    const unsigned gen = old / nloc;
    if (old + 1u == (gen + 1u) * nloc) {
      __builtin_amdgcn_fence(__ATOMIC_RELEASE, "agent");
      asm volatile("s_waitcnt vmcnt(0)" ::: "memory");
      const unsigned og = xb_add(&bar[XB_TOP], 1u);
      const unsigned tg = og / nx;
      if (og + 1u == (tg + 1u) * nx) xb_add(&bar[XB_TOPGEN], 1u);
      else XB_SPIN(xb_ld(&bar[XB_TOPGEN]) == tg, bar);
      __builtin_amdgcn_fence(__ATOMIC_ACQUIRE, "agent");
      xb_add(&bar[XB_XGEN(b.x)], 1u);
      asm volatile("s_waitcnt vmcnt(0)" ::: "memory");
    } else {
      XB_SPIN(xb_ld(&bar[XB_XGEN(b.x)]) == gen, bar);
      __builtin_amdgcn_fence(__ATOMIC_ACQUIRE, "agent");
      asm volatile("s_waitcnt vmcnt(0)" ::: "memory");
    }
  }
  __syncthreads();
}

constexpr int N_PHASES = 18;
#define PANEL_CNT_WORD0 3584
#define NORM_FUSED (gridDim.x >= 192u)
#ifndef REP_PHASE
#define REP_PHASE -1
#endif
#ifndef REP_PART
#define REP_PART 0
#endif

template <int PH>
DI void run_phase() {
  const int rep = 0;
    PP p = get_pp();
    const float* Xw = (const float*)(p->ws + OFF_X);
    GemmDesc d;
    d.act_pn_step = 0; d.a_kstep = 128; d.a_tstep = 0; d.kind = -1; d.layer = 0;
    d.W = nullptr; d.Act = nullptr; d.ldw = 0; d.lda = 0; d.K = 0; d.nN = 0;
    switch (PH) {
      case 0: phase_mod_partial(p); break;
      case 1: phase_prep(p, 0, blockIdx.x, gridDim.x); break;
      case 2: phase_norm(p, p->x_prompt, p->x_sample, 0, 0, 0); break;
      case 3: d.W = (const bf16_t*)(p->ws + OFF_WIN); d.ldw = 1024; d.Act = (const bf16_t*)(p->ws + OFF_HN); d.lda = 1024;
              d.K = 1024; d.nN = 8; d.kind = EPI_INPROJ; d.layer = 0; break;
#ifndef NO_P4
      case 4: phase_attn_s5a(p, 0); break;
#endif
#ifndef NO_P5
      case 5: phase_s5c(p); break;
#endif
      case 6: d.W = (const bf16_t*)(p->ws + OFF_WGLU); d.ldw = 512; d.Act = (const bf16_t*)(p->ws + OFF_GS5); d.lda = 512;
              d.K = 512; d.nN = 2; d.kind = EPI_GLU; break;
      case 7: d.W = (const bf16_t*)(p->ws + OFF_WOUT); d.ldw = 1024; d.Act = (const bf16_t*)(p->ws + OFF_CAT); d.lda = 1024;
              d.K = 1024; d.nN = 4; d.kind = EPI_OUTPROJ; d.layer = 0; break;
      case 8: if (!NORM_FUSED) phase_norm(p, Xw, Xw + 4096ull * 1024, 0, 3, 0); break;
      case 9: d.W = (const bf16_t*)(p->ws + OFF_W1); d.ldw = 1024; d.Act = (const bf16_t*)(p->ws + OFF_HN); d.lda = 1024;
              d.K = 1024; d.nN = 16; d.kind = EPI_FF1; break;
      case 10: d.W = (const bf16_t*)(p->ws + OFF_W2); d.ldw = 4096; d.Act = (const bf16_t*)(p->ws + OFF_H); d.lda = 64; d.a_kstep = 32768; d.a_tstep = 2097152;
               d.K = 4096; d.nN = 4; d.kind = EPI_FF2; d.layer = 0; break;
      case 11: if (!NORM_FUSED) phase_norm(p, Xw, Xw + 4096ull * 1024, 1, 0, 1); break;
      case 12: phase_pool_z(p); break;
      case 13: d.W = (const bf16_t*)(p->ws + OFF_WPOOL); d.ldw = 256; d.Act = (const bf16_t*)(p->ws + OFF_HN); d.lda = 1024;
               d.K = 256; d.nN = 4; d.act_pn_step = 512; d.kind = EPI_POOL; d.layer = 1; break;
      case 14: if (!NORM_FUSED) phase_norm(p, Xw, Xw + 4096ull * 1024, 1, 3, 0); break;
      case 15: d.W = (const bf16_t*)(p->ws + OFF_W1) + 4194304ull; d.ldw = 1024; d.Act = (const bf16_t*)(p->ws + OFF_HN); d.lda = 1024;
               d.K = 1024; d.nN = 16; d.kind = EPI_FF1; break;
      case 16: d.W = (const bf16_t*)(p->ws + OFF_W2) + 4194304ull; d.ldw = 4096; d.Act = (const bf16_t*)(p->ws + OFF_H); d.lda = 64; d.a_kstep = 32768; d.a_tstep = 2097152;
               d.K = 4096; d.nN = 4; d.kind = EPI_FF2; d.layer = 1; break;
      case 17: if (!NORM_FUSED) phase_norm(p, Xw, Xw + 4096ull * 1024, 0, 0, 2); break;
    }
#ifndef NO_GEMM
    if (d.kind >= 0) gemm_phase(p, d);
#endif
    if ((PH == 7 || PH == 10 || PH == 13 || PH == 16) && NORM_FUSED) {
      Unit u;
      if (unit_next(0, 48, 4, gridDim.x, blockIdx.x, u)) {
        const int slot = PH == 7 ? 0 : PH == 10 ? 1 : PH == 13 ? 2 : 3;
        unsigned* cnt = (unsigned*)(p->ws + OFF_BAR) + PANEL_CNT_WORD0 + slot * 64 + u.pm;
        if (threadIdx.x == 0) {
          __builtin_amdgcn_fence(__ATOMIC_RELEASE, "agent");
          asm volatile("s_waitcnt vmcnt(0)" ::: "memory");
          (void)xb_add(cnt, 1u);
          unsigned spins = 0;
          while (xb_ld(cnt) < 4u) { __builtin_amdgcn_s_sleep(2); if (++spins > (1u << 22)) break; }
          __builtin_amdgcn_fence(__ATOMIC_ACQUIRE, "agent");
          asm volatile("s_waitcnt vmcnt(0)" ::: "memory");
        }
        __syncthreads();
        const int rb = u.pm * 256 + u.pn * 64;
        const int wv = (int)(threadIdx.x >> 6);
        if (PH == 7)  phase_norm(p, Xw, Xw + 4096ull * 1024, 0, 3, 0, rb, rb + 64, wv, 8);
        if (PH == 10) phase_norm(p, Xw, Xw + 4096ull * 1024, 1, 0, 1, rb, rb + 64, wv, 8);
        if (PH == 13) phase_norm(p, Xw, Xw + 4096ull * 1024, 1, 3, 0, rb, rb + 64, wv, 8);
        if (PH == 16) phase_norm(p, Xw, Xw + 4096ull * 1024, 0, 0, 2, rb, rb + 64, wv, 8);
      }
    }
    if (rep == 0) {
      if (PH == 3) {
        const int first = gridDim.x >> 1, nb = gridDim.x - first;
        if ((int)blockIdx.x >= first) {
          const int tid = opaque_tid();
          const int bid = blockIdx.x - first;
          for (int it = bid; it < 512; it += nb) transpose_item(p, it < 256 ? 224 + it : 736 + (it - 256), tid);
          phase_prep(p, 1, bid, nb);
        }
      }
      if (PH == 10) {
        const int first = (gridDim.x * 3) >> 2, nb = gridDim.x - first;
        if ((int)blockIdx.x >= first) {
          const int tid = opaque_tid();
          for (int it = blockIdx.x - first; it < 512; it += nb) transpose_item(p, it < 256 ? 480 + it : 992 + (it - 256), tid);
        }
      }
    }
}
template <int PH>
DI void run_from(cg::grid_group& grid) {
  if constexpr (PH < N_PHASES) {
    if constexpr (PH > 0) {
      XcdBarrier xb; xb.bar = (unsigned*)(get_pp()->ws + OFF_BAR); xb.x = xb_xcc_id();
      xb.st = (volatile XLAS unsigned*)((XLAS unsigned char*)g_smem + LDS_ST_OFF);
      if constexpr (PH == 1) { grid.sync(); if (threadIdx.x == 0) (void)xb_add(&xb.bar[XB_XCNT(xb.x)], 1u); }
      else if (!((PH == 8 || PH == 11 || PH == 14 || PH == 17) && NORM_FUSED)) xcd_barrier(xb);
    }
    if constexpr (PH == REP_PHASE && PH >= 2) {
      run_phase<PH>();
      XcdBarrier xb2; xb2.bar = (unsigned*)(get_pp()->ws + OFF_BAR); xb2.x = xb_xcc_id();
      xb2.st = (volatile XLAS unsigned*)((XLAS unsigned char*)g_smem + LDS_ST_OFF);
      xcd_barrier(xb2);
    }
    run_phase<PH>();
    run_from<PH + 1>(grid);
  }
}

__global__ void __launch_bounds__(NTHREADS) mega(Params pk) {
  cg::grid_group grid = cg::this_grid();
  unsigned* bar = (unsigned*)(get_pp()->ws + OFF_BAR);
  volatile XLAS unsigned* st = (volatile XLAS unsigned*)((XLAS unsigned char*)g_smem + LDS_ST_OFF);
  if (threadIdx.x == 0) { st[0] = 0u; st[1] = 0u; st[2] = 0u; st[3] = 0u; }
  if (blockIdx.x == 0) {
    for (int i = threadIdx.x; i < 4096; i += NTHREADS) __hip_atomic_store(&bar[i], 0u, __ATOMIC_RELAXED, __HIP_MEMORY_SCOPE_AGENT);
    __threadfence();
  }
  __syncthreads();
  run_from<0>(grid);
}

extern "C" void kernel_launch(void* const* d_in, const int* in_sizes, int n_in, void* d_out, int out_size,
                              void* d_ws, size_t ws_size, hipStream_t stream) {
  static int grid_blocks = 0;
  if (!grid_blocks) {
    int dev = 0, cus = 0, per_cu = 0;
    hipGetDevice(&dev);
    hipFuncSetAttribute((const void*)mega, hipFuncAttributeMaxDynamicSharedMemorySize, SHM_BYTES);
    hipDeviceGetAttribute(&cus, hipDeviceAttributeMultiprocessorCount, dev);
    hipOccupancyMaxActiveBlocksPerMultiprocessor(&per_cu, mega, NTHREADS, SHM_BYTES);
    if (per_cu > 1) per_cu = 1;
    grid_blocks = cus * per_cu;
  }
  if (ws_size < WS_NEEDED) fprintf(stderr, "workspace too small: %zu < %zu\n", ws_size, (size_t)WS_NEEDED);
  Params p{};
  const float** pf = (const float**)&p;
  for (int i = 0; i < 28; ++i) pf[i] = (const float*)d_in[i];
  p.out = (float*)d_out;
  p.ws = (char*)d_ws;
  p.phase_lo = 0;
  p.phase_hi = N_PHASES;
  p.rep_phase = -1;
  void* args[] = {&p};
  hipError_t e = hipLaunchCooperativeKernel((void*)mega, dim3(grid_blocks), dim3(NTHREADS), args, SHM_BYTES, stream);
  if (e != hipSuccess) fprintf(stderr, "cooperative launch failed: %s (grid %d)\n", hipGetErrorString(e), grid_blocks);
}
```

```cpp
#include <hip/hip_runtime.h>
#include <hip/hip_cooperative_groups.h>
#include <cstdio>
namespace cg = cooperative_groups;

#define DI __device__ __forceinline__
typedef unsigned short bf16_t;
using bf16x8 = __attribute__((ext_vector_type(8))) short;
using f32x4  = __attribute__((ext_vector_type(4))) float;
using f32x16 = __attribute__((ext_vector_type(16))) float;
using u32x4  = __attribute__((ext_vector_type(4))) unsigned;
using u32x2  = __attribute__((ext_vector_type(2))) unsigned;
typedef __bf16 bf2_t __attribute__((ext_vector_type(2)));
typedef float fl2_t __attribute__((ext_vector_type(2)));

constexpr int NTHREADS = 512;
constexpr int T_ALL = 12288;
constexpr int LDS_ST_OFF = 139264;
constexpr int LDS_STATS_OFF = LDS_ST_OFF + 64;
constexpr int SHM_BYTES = LDS_STATS_OFF + 4096;

constexpr size_t OFF_MODP = 0;
constexpr size_t SZ_MODP  = 32ull * 2 * 5 * 6144 * 4;
constexpr size_t OFF_MODF = OFF_MODP + SZ_MODP;
constexpr size_t SZ_MODF  = 2ull * 5 * 6 * 1024 * 4;
constexpr size_t OFF_WIN  = OFF_MODF + SZ_MODF;
constexpr size_t SZ_WIN   = 2048ull * 1024 * 2;
constexpr size_t OFF_WOUT = OFF_WIN + SZ_WIN;
constexpr size_t SZ_WOUT  = 1024ull * 1024 * 2;
constexpr size_t OFF_WGLU = OFF_WOUT + SZ_WOUT;
constexpr size_t SZ_WGLU  = 512ull * 512 * 2;
constexpr size_t OFF_WPOOL = OFF_WGLU + SZ_WGLU;
constexpr size_t SZ_WPOOL = 4ull * 256 * 256 * 2;
constexpr size_t OFF_W1   = OFF_WPOOL + SZ_WPOOL;
constexpr size_t SZ_W1    = 2ull * 4096 * 1024 * 2;
constexpr size_t OFF_W2   = OFF_W1 + SZ_W1;
constexpr size_t SZ_W2    = 2ull * 1024 * 4096 * 2;
constexpr size_t OFF_HN   = OFF_W2 + SZ_W2;
constexpr size_t SZ_HN    = 12288ull * 1024 * 2;
constexpr size_t OFF_X    = OFF_HN + SZ_HN;
constexpr size_t SZ_X     = 12288ull * 1024 * 4;
constexpr size_t OFF_RSTD = OFF_X + SZ_X;
constexpr size_t SZ_RSTD  = 12288ull * 4;
constexpr size_t OFF_S5TA = OFF_RSTD + SZ_RSTD;
constexpr size_t SZ_S5TA  = 2ull * 32 * 64 * 16;
constexpr size_t OFF_S5TB = OFF_S5TA + SZ_S5TA;
constexpr size_t SZ_S5TB  = 2ull * 32 * 8 * 64 * 16;
constexpr size_t OFF_S5TC = OFF_S5TB + SZ_S5TB;
constexpr size_t SZ_S5TC  = 2ull * 32 * 4 * 64 * 16;
constexpr size_t OFF_BAR  = OFF_S5TC + SZ_S5TC;
constexpr size_t SZ_BAR   = 16384;
constexpr size_t OFF_R    = OFF_BAR + SZ_BAR;
constexpr size_t OFF_Q    = OFF_R;
constexpr size_t SZ_Q     = 12288ull * 512 * 2;
constexpr size_t OFF_K    = OFF_Q + SZ_Q;
constexpr size_t SZ_K     = 14336ull * 512 * 2;
constexpr size_t OFF_V    = OFF_K + SZ_K;
constexpr size_t SZ_V     = SZ_K;
constexpr size_t OFF_U    = OFF_V + SZ_V;
constexpr size_t SZ_U     = 12288ull * 512 * 4;
constexpr size_t OFF_E    = OFF_U + SZ_U;
constexpr size_t SZ_E     = 192ull * 32 * 2 * 64 * 2 * 4;
constexpr size_t OFF_GS5  = OFF_E + SZ_E;
constexpr size_t SZ_GS5   = 12288ull * 512 * 2;
constexpr size_t OFF_CAT  = OFF_GS5 + SZ_GS5;
constexpr size_t SZ_CAT   = 12288ull * 1024 * 2;
constexpr size_t END_MIX  = OFF_CAT + SZ_CAT;
constexpr size_t OFF_H    = OFF_R;
constexpr size_t SZ_H     = 12288ull * 4096 * 2;
constexpr size_t END_H    = OFF_H + SZ_H;
constexpr size_t WS_NEEDED = END_MIX > END_H ? END_MIX : END_H;

constexpr size_t OUT_Y  = 0;
constexpr size_t OUT_K  = 12288ull * 1024;
constexpr size_t OUT_V  = OUT_K + 4096ull * 512;
constexpr size_t OUT_S  = OUT_V + 4096ull * 512;

struct Params {
  const float *x_prompt, *x_sample, *cache_k, *cache_v, *state_s5, *c, *c_ctx, *mod_w, *mod_b, *norm_g,
      *w_in, *w_out, *dl_qk, *subln_g, *lam_re, *lam_im, *log_dt, *b_re, *b_im, *c_re, *c_im, *s5_d, *w_glu,
      *pool_w, *pool_scale, *ff_w1, *ff_w2, *final_g;
  float* out;
  char* ws;
  int phase_lo, phase_hi;
  int rep_phase, pad0;
};

typedef const Params __attribute__((address_space(4)))* PP;
extern __shared__ __attribute__((aligned(16))) char g_smem[];
DI PP get_pp() { PP kp = (PP)__builtin_amdgcn_kernarg_segment_ptr(); asm volatile("" : "+s"(kp)); return kp; }

DI unsigned pk2(float a, float b) {
  fl2_t f = {a, b};
  bf2_t r = __builtin_convertvector(f, bf2_t);
  return __builtin_bit_cast(unsigned, r);
}
DI bf16_t f2bf(float a) { return (bf16_t)(pk2(a, 0.f) & 0xffffu); }
DI float bf2f(bf16_t v) { return __uint_as_float(((unsigned)v) << 16); }
DI void wave_lds_sync() { asm volatile("s_waitcnt lgkmcnt(0)" ::: "memory"); __builtin_amdgcn_wave_barrier(); }
DI float wave_sum(float v) {
  v += __shfl_xor(v, 32); v += __shfl_xor(v, 16); v += __shfl_xor(v, 8);
  v += __shfl_xor(v, 4);  v += __shfl_xor(v, 2);  v += __shfl_xor(v, 1);
  return v;
}
DI int opaque_tid() { int t = threadIdx.x; asm volatile("" : "+v"(t)); return t; }
DI int mod_row(int tok) { return tok < 4096 ? 0 : 1 + ((tok - 4096) >> 11); }
DI int kv_row(int tok) {
  if (tok < 4096) return tok;
  int b = (tok - 4096) >> 11, l = (tok - 4096) & 2047;
  return 4096 + b * 2560 + l;
}
DI size_t vf_off(int base_rows, int nkt, int h, int kt, int dt, int s, int lane) {
  return (size_t)base_rows * 512 + ((((size_t)(h * nkt + kt) * 4 + dt) * 2 + s) * 64 + lane) * 8;
}

DI size_t kf_off(int base_rows, int nkt, int h, int m, int kt, int s, int lane) {
  return (size_t)base_rows * 512 + ((((size_t)((h * 2 + m) * nkt + kt)) * 4 + s) * 64 + lane) * 8;
}

DI void phase_mod_partial(PP p) {
  const int tid = opaque_tid();
  float* s_silu = (float*)g_smem;
  float* modp = (float*)(p->ws + OFF_MODP);
  const int nitems = 2 * 12 * 32;
  for (int it = blockIdx.x; it < nitems; it += gridDim.x) {
    int ks = it & 31, cc = (it >> 5) % 12, l = it / (32 * 12);
    __syncthreads();
    if (tid < 160) {
      int r = tid >> 5, k = tid & 31, kk = ks * 32 + k;
      float v = r == 0 ? p->c_ctx[kk] : p->c[(r - 1) * 1024 + kk];
      s_silu[tid] = v / (1.f + expf(-v));
    }
    __syncthreads();
    int n = cc * 512 + tid;
    const float* w = p->mod_w + ((size_t)l * 1024 + ks * 32) * 6144 + n;
    float a0 = 0, a1 = 0, a2 = 0, a3 = 0, a4 = 0;
#pragma unroll 8
    for (int k = 0; k < 32; ++k) {
      float wv = __builtin_nontemporal_load(w + (size_t)k * 6144);
      a0 += s_silu[k] * wv; a1 += s_silu[32 + k] * wv; a2 += s_silu[64 + k] * wv;
      a3 += s_silu[96 + k] * wv; a4 += s_silu[128 + k] * wv;
    }
    float* o = modp + ((size_t)(ks * 2 + l) * 5) * 6144 + n;
    o[0] = a0; o[6144] = a1; o[2 * 6144] = a2; o[3 * 6144] = a3; o[4 * 6144] = a4;
  }
}

DI void transpose_tile4(const float* __restrict__ src, int K, int N, bf16_t* __restrict__ dst, int tk, int tn4, int tid) {
  float* tile = (float*)g_smem;
  float4 v[8];
#pragma unroll
  for (int i = 0; i < 8; ++i) {
    int idx = tid + 512 * i, r = idx >> 6, c4 = (idx & 63) * 4;
    { const f32x4 t_ = __builtin_nontemporal_load((const f32x4*)(src + (size_t)(tk * 64 + r) * N + tn4 * 256 + c4)); v[i] = float4{t_[0], t_[1], t_[2], t_[3]}; }
  }
  __syncthreads();
#pragma unroll
  for (int i = 0; i < 8; ++i) {
    int idx = tid + 512 * i, r = idx >> 6, c4 = (idx & 63) * 4;
    float* t = tile + (c4 >> 6) * (64 * 65) + r * 65 + (c4 & 63);
    t[0] = v[i].x; t[1] = v[i].y; t[2] = v[i].z; t[3] = v[i].w;
  }
  __syncthreads();
#pragma unroll
  for (int q = 0; q < 4; ++q) {
    int n = tid >> 3, kc = tid & 7;
    const float* t = tile + q * (64 * 65);
    u32x4 o;
    for (int j = 0; j < 4; ++j)
      o[j] = pk2(t[(kc * 8 + 2 * j) * 65 + n], t[(kc * 8 + 2 * j + 1) * 65 + n]);
    *(u32x4*)(dst + (size_t)(tn4 * 256 + q * 64 + n) * K + tk * 64 + kc * 8) = o;
  }
}

DI void cmul(float ar, float ai, float br, float bi, float& cr, float& ci) { cr = ar * br - ai * bi; ci = ar * bi + ai * br; }
DI void s5_disc(PP p, int dr, int g, int pp, float& a_re, float& a_im, float& f_re, float& f_im) {
  const int idx = (dr * 32 + g) * 64 + pp;
  const float lr = p->lam_re[idx], li = p->lam_im[idx];
  const float dt = expf(p->log_dt[dr * 32 + g]);
  const float mag = expf(lr * dt), ang = li * dt;
  a_re = mag * cosf(ang); a_im = mag * sinf(ang);
  const float den = lr * lr + li * li;
  f_re = ((a_re - 1.f) * lr + a_im * li) / den;
  f_im = (a_im * lr - (a_re - 1.f) * li) / den;
}

DI void s5_build_tables(PP p, int dr, int g, int lane) {
  const int fr = lane & 15, fq = lane >> 4;
  float a_re, a_im, f_re, f_im;
  s5_disc(p, dr, g, lane, a_re, a_im, f_re, f_im);
  float A64r = a_re, A64i = a_im;
#pragma unroll
  for (int i = 0; i < 6; ++i) { float tr, ti; cmul(A64r, A64i, A64r, A64i, tr, ti); A64r = tr; A64i = ti; }
  ((float4*)(p->ws + OFF_S5TA))[(dr * 32 + g) * 64 + lane] = float4{a_re, a_im, A64r, A64i};
  u32x4* tb = (u32x4*)(p->ws + OFF_S5TB) + (size_t)((dr * 32 + g) * 8) * 64 + lane;
#pragma unroll
  for (int nt = 0; nt < 4; ++nt) {
    float are, aim, fre, fim;
    const int pp = 16 * nt + fr;
    s5_disc(p, dr, g, pp, are, aim, fre, fim);
    u32x4 ore = {0, 0, 0, 0}, oim = {0, 0, 0, 0};
    if (fq < 2) {
      const size_t bo = ((size_t)((dr * 32 + g) * 64 + pp)) * 16 + 8 * fq;
      float br[8], bi[8];
      *(float4*)&br[0] = *(const float4*)(p->b_re + bo); *(float4*)&br[4] = *(const float4*)(p->b_re + bo + 4);
      *(float4*)&bi[0] = *(const float4*)(p->b_im + bo); *(float4*)&bi[4] = *(const float4*)(p->b_im + bo + 4);
#pragma unroll
      for (int j = 0; j < 4; ++j) {
        float r0 = fre * br[2 * j] - fim * bi[2 * j], r1 = fre * br[2 * j + 1] - fim * bi[2 * j + 1];
        float i0 = fre * bi[2 * j] + fim * br[2 * j], i1 = fre * bi[2 * j + 1] + fim * br[2 * j + 1];
        ore[j] = pk2(r0, r1); oim[j] = pk2(i0, i1);
      }
    }
    tb[nt * 64] = ore; tb[(4 + nt) * 64] = oim;
  }
  u32x4* tc = (u32x4*)(p->ws + OFF_S5TC) + (size_t)((dr * 32 + g) * 4) * 64 + lane;
#pragma unroll
  for (int ks = 0; ks < 4; ++ks) {
    const int k0 = 32 * ks + 8 * fq;
    const float* src = (k0 < 64 ? p->c_re : p->c_im) + ((size_t)((dr * 32 + g) * 16 + fr)) * 64 + (k0 & 63);
    const float sg = k0 < 64 ? 1.f : -1.f;
    float4 v0 = *(const float4*)src, v1 = *(const float4*)(src + 4);
    tc[ks * 64] = u32x4{pk2(sg * v0.x, sg * v0.y), pk2(sg * v0.z, sg * v0.w), pk2(sg * v1.x, sg * v1.y), pk2(sg * v1.z, sg * v1.w)};
  }
}

DI void transpose_item(PP p, int tix, int tid) {
  const float* src; bf16_t* dst; int K, N, local;
  if (tix < 128) { src = p->w_in; K = 1024; N = 2048; dst = (bf16_t*)(p->ws + OFF_WIN); local = tix; }
  else if (tix < 192) { src = p->w_out; K = 1024; N = 1024; dst = (bf16_t*)(p->ws + OFF_WOUT); local = tix - 128; }
  else if (tix < 208) { src = p->w_glu; K = 512; N = 512; dst = (bf16_t*)(p->ws + OFF_WGLU); local = tix - 192; }
  else if (tix < 224) { int g = (tix - 208) >> 2; src = p->pool_w + (size_t)g * 65536; K = 256; N = 256;
                        dst = (bf16_t*)(p->ws + OFF_WPOOL) + (size_t)g * 65536; local = (tix - 208) & 3; }
  else if (tix < 736) { int l = (tix - 224) >> 8; src = p->ff_w1 + (size_t)l * 4194304; K = 1024; N = 4096;
                        dst = (bf16_t*)(p->ws + OFF_W1) + (size_t)l * 4194304; local = (tix - 224) & 255; }
  else { int l = (tix - 736) >> 8; src = p->ff_w2 + (size_t)l * 4194304; K = 4096; N = 1024;
         dst = (bf16_t*)(p->ws + OFF_W2) + (size_t)l * 4194304; local = (tix - 736) & 255; }
  int tpr = N >> 8;
  transpose_tile4(src, K, N, dst, local / tpr, local % tpr, tid);
}

DI void phase_prep(PP p, int part, int bid, int nb) {
  const int tid = opaque_tid();
  const float* modp = (const float*)(p->ws + OFF_MODP);
  float* modf = (float*)(p->ws + OFF_MODF);
  const int N_FIN = 120, N_TR = 224, N_CK = 256, N_CV = 256, N_S5 = 8;
  const int nitems = N_FIN + N_TR + N_CK + N_CV + N_S5;
  const int it_lo = part == 0 ? 0 : N_FIN + N_TR, it_hi = part == 0 ? N_FIN + N_TR : nitems;
  for (int it = it_lo + bid; it < it_hi; it += nb) {
    if (it < N_FIN) {
      const int idx = it * 512 + tid;
      const int l = idx / 30720, rem = idx - l * 30720, r = rem / 6144, c = rem - r * 6144, j = c >> 10, n = c & 1023;
      float part[32];
#pragma unroll
      for (int ks = 0; ks < 32; ++ks) part[ks] = modp[((size_t)(ks * 2 + l) * 5 + r) * 6144 + c];
      float sum = p->mod_b[l * 6144 + c];
#pragma unroll
      for (int ks = 0; ks < 32; ++ks) sum += part[ks];
      float* o = modf + (size_t)((l * 5 + r) * 6) * 1024 + n;
      if (j == 0) o[1024] = sum;
      else if (j == 1) o[0] = p->norm_g[(l * 2 + 0) * 1024 + n] * (1.f + sum);
      else if (j == 2) o[2 * 1024] = sum;
      else if (j == 3) o[4 * 1024] = sum;
      else if (j == 4) o[3 * 1024] = p->norm_g[(l * 2 + 1) * 1024 + n] * (1.f + sum);
      else o[5 * 1024] = sum;
    } else if (it < N_FIN + N_TR) {
      transpose_item(p, it - N_FIN, tid);
    } else if (it < N_FIN + N_TR + N_CK) {
      int idx = (it - N_FIN - N_TR) * 512 + tid;
      int lane = idx & 63, s = (idx >> 6) & 3, kt16 = (idx >> 8) & 15, mm = (idx >> 12) & 1, h = (idx >> 13) & 3, b = idx >> 15;
      int key = 32 * kt16 + (lane & 31), hh = lane >> 5;
      const float* src = p->cache_k + ((size_t)(b * 512 + key) * 4 + h) * 128 + mm * 64 + 16 * s + 8 * hh;
      float4 v0 = *(const float4*)src, v1 = *(const float4*)(src + 4);
      u32x4 o = {pk2(v0.x, v0.y), pk2(v0.z, v0.w), pk2(v1.x, v1.y), pk2(v1.z, v1.w)};
      bf16_t* Kb = (bf16_t*)(p->ws + OFF_K);
      *(u32x4*)(Kb + kf_off(4096 + b * 2560, 80, h, mm, 64 + kt16, s, lane)) = o;
    } else if (it >= N_FIN + N_TR + N_CK + N_CV) {
      const int w = (it - (N_FIN + N_TR + N_CK + N_CV)) * 8 + (tid >> 6);
      s5_build_tables(p, w >> 5, w & 31, tid & 63);
    } else {
      int idx = (it - N_FIN - N_TR - N_CK) * 512 + tid;
      int lane = idx & 63, s = (idx >> 6) & 1, dt = (idx >> 7) & 3, kt16 = (idx >> 9) & 15, h = (idx >> 13) & 3, b = idx >> 15;
      int hh = lane >> 5, dd = 32 * dt + (lane & 31);
      float v[8];
#pragma unroll
      for (int j = 0; j < 8; ++j) {
        int kk = 16 * s + 8 * (j >> 2) + 4 * hh + (j & 3);
        int key = 32 * kt16 + kk;
        v[j] = p->cache_v[((size_t)(b * 512 + key) * 4 + h) * 128 + dd];
      }
      u32x4 o = {pk2(v[0], v[1]), pk2(v[2], v[3]), pk2(v[4], v[5]), pk2(v[6], v[7])};
      bf16_t* Vf = (bf16_t*)(p->ws + OFF_V);
      *(u32x4*)(Vf + vf_off(4096 + b * 2560, 80, h, 64 + kt16, dt, s, lane)) = o;
    }
  }
}

DI void phase_norm(PP p, const float* xa, const float* xb, int layer, int jalpha, int mode, int rbeg = 0, int rend = T_ALL, int widx = -1, int nwv = 0) {
  const int tid = opaque_tid();
  const int lane = tid & 63, wid = tid >> 6;
  const int nW = widx < 0 ? gridDim.x * 8 : nwv, gw = widx < 0 ? (int)blockIdx.x * 8 + wid : rbeg + widx;
  const int T_END = rend;
  const float* modf = (const float*)(p->ws + OFF_MODF);
  bf16_t* hn = (bf16_t*)(p->ws + OFF_HN);
  float* rstd_buf = (float*)(p->ws + OFF_RSTD);
  constexpr int R = 3;
  for (int row0 = gw; row0 < T_END; row0 += nW * R) {
    float4 v[R][4];
    float ss[R];
#pragma unroll
    for (int r = 0; r < R; ++r) {
      const int row = row0 + r * nW;
      ss[r] = 0.f;
      if (row < T_END) {
        const float* x = row < 4096 ? xa + (size_t)row * 1024 : xb + (size_t)(row - 4096) * 1024;
#pragma unroll
        for (int i = 0; i < 4; ++i) {
          if (mode == 0 && layer == 0 && jalpha == 0) {
            const f32x4 t_ = __builtin_nontemporal_load((const f32x4*)(x + i * 256 + lane * 4)); v[r][i] = float4{t_[0], t_[1], t_[2], t_[3]};
          } else v[r][i] = *(const float4*)(x + i * 256 + lane * 4);
        }
      } else {
#pragma unroll
        for (int i = 0; i < 4; ++i) v[r][i] = float4{0.f, 0.f, 0.f, 0.f};
      }
    }
#pragma unroll
    for (int r = 0; r < R; ++r) {
#pragma unroll
      for (int i = 0; i < 4; ++i)
        ss[r] += v[r][i].x * v[r][i].x + v[r][i].y * v[r][i].y + v[r][i].z * v[r][i].z + v[r][i].w * v[r][i].w;
      ss[r] = wave_sum(ss[r]);
    }
#pragma unroll
    for (int r = 0; r < R; ++r) {
      const int row = row0 + r * nW;
      if (row >= T_END) continue;
      const float rstd = rsqrtf(ss[r] * (1.f / 1024.f) + 1e-6f);
      if (mode == 1) { if (lane == 0) rstd_buf[row] = rstd; continue; }
      if (mode == 2) {
#pragma unroll
        for (int i = 0; i < 4; ++i) {
          float4 g = *(const float4*)(p->final_g + i * 256 + lane * 4);
          float4 o = {v[r][i].x * rstd * g.x, v[r][i].y * rstd * g.y, v[r][i].z * rstd * g.z, v[r][i].w * rstd * g.w};
          __builtin_nontemporal_store(f32x4{o.x, o.y, o.z, o.w}, (f32x4*)(p->out + OUT_Y + (size_t)row * 1024 + i * 256 + lane * 4));
        }
        continue;
      }
      const float* al = modf + (size_t)((layer * 5 + mod_row(row)) * 6 + jalpha) * 1024;
      const float* be = al + 1024;
#pragma unroll
      for (int i = 0; i < 4; ++i) {
        float4 a = *(const float4*)(al + i * 256 + lane * 4);
        float4 b = *(const float4*)(be + i * 256 + lane * 4);
        u32x2 o = {pk2(v[r][i].x * rstd * a.x + b.x, v[r][i].y * rstd * a.y + b.y),
                   pk2(v[r][i].z * rstd * a.z + b.z, v[r][i].w * rstd * a.w + b.w)};
        *(u32x2*)(hn + (size_t)row * 1024 + i * 256 + lane * 4) = o;
      }
    }
  }
}

constexpr int PNT = 4;
template <int HW>
DI void pool_windows(const float* __restrict__ X, const float* __restrict__ rstd, int base, int l, int L, int c, float4 (&sout)[PNT]) {
  constexpr int NR = 2 * HW + PNT - 1;
  float4 v[NR];
#pragma unroll
  for (int i = 0; i < NR; ++i) {
    const int q = l - HW + i;
    const bool ok = q >= 0 && q < L;
    const int qq = ok ? q : l;
    const float r = ok ? rstd[base + qq] : 0.f;
    const float4 x = *(const float4*)(X + (size_t)(base + qq) * 1024 + c);
    v[i] = float4{x.x * r, x.y * r, x.z * r, x.w * r};
  }
  float4 s = {0.f, 0.f, 0.f, 0.f};
#pragma unroll
  for (int i = 0; i < 2 * HW; ++i) { s.x += v[i].x; s.y += v[i].y; s.z += v[i].z; s.w += v[i].w; }
  sout[0] = s;
#pragma unroll
  for (int k = 1; k < PNT; ++k) {
    s.x += v[k - 1 + 2 * HW].x - v[k - 1].x; s.y += v[k - 1 + 2 * HW].y - v[k - 1].y;
    s.z += v[k - 1 + 2 * HW].z - v[k - 1].z; s.w += v[k - 1 + 2 * HW].w - v[k - 1].w;
    sout[k] = s;
  }
}
DI void phase_pool_z(PP p) {
  const int tid = opaque_tid();
  const float* X = (const float*)(p->ws + OFF_X);
  const float* rstd = (const float*)(p->ws + OFF_RSTD);
  const float* modf = (const float*)(p->ws + OFF_MODF);
  bf16_t* Z = (bf16_t*)(p->ws + OFF_HN);
  const int total = (T_ALL / PNT) * 256;
  for (int idx = blockIdx.x * NTHREADS + tid; idx < total; idx += gridDim.x * NTHREADS) {
    const int tok = (idx >> 8) * PNT, c = (idx & 255) * 4;
    const int grp = c >> 8, hw = 1 << grp;
    int base, l, L;
    if (tok < 4096) { base = tok & ~255; l = tok & 255; L = 256; }
    else { int t2 = tok - 4096; base = 4096 + (t2 & ~2047); l = t2 & 2047; L = 2048; }
    float4 sw[PNT];
    if (grp == 0) pool_windows<1>(X, rstd, base, l, L, c, sw);
    else if (grp == 1) pool_windows<2>(X, rstd, base, l, L, c, sw);
    else if (grp == 2) pool_windows<4>(X, rstd, base, l, L, c, sw);
    else pool_windows<8>(X, rstd, base, l, L, c, sw);
    const float4 a = *(const float4*)(modf + (size_t)((1 * 5 + mod_row(tok)) * 6 + 0) * 1024 + c);
#pragma unroll
    for (int k = 0; k < PNT; ++k) {
      const int lk = l + k;
      const int lo = max(lk - hw, 0), hi = min(lk + hw, L);
      const float inv = 1.f / (float)(hi - lo);
      const float r0 = rstd[tok + k];
      const float4 v0 = *(const float4*)(X + (size_t)(tok + k) * 1024 + c);
      const float4 s = sw[k];
      u32x2 o = {pk2(a.x * (s.x * inv - v0.x * r0), a.y * (s.y * inv - v0.y * r0)),
                 pk2(a.z * (s.z * inv - v0.z * r0), a.w * (s.w * inv - v0.w * r0))};
      *(u32x2*)(Z + (size_t)(tok + k) * 1024 + c) = o;
    }
  }
}

#define LAS __attribute__((address_space(3)))
constexpr int BM = 256, BK = 64, HALF = 128, HTB = HALF * BK * 2, NXCD = 8, WGM = 8;
DI int lds_byte(int r, int c) {
  const int st = (r >> 4) * 2 + (c >> 5), rr = r & 15, cc = c & 31, ob = rr * 64 + cc * 2;
  return st * 1024 + (ob ^ (((ob >> 9) & 1) << 5));
}
DI void stage_rc(int b, int& R, int& C) {
  const int st = b / 1024, sb = b % 1024, swz = sb ^ (((sb >> 9) & 1) << 5);
  R = (st >> 1) * 16 + swz / 64; C = (st & 1) * 32 + (swz % 64) / 2;
}
struct Unit { int pm, pn; };
DI bool unit_next(int i, int nM, int nN, int G, int c, Unit& u) {
  const int nwg = nM * nN;
  const long L = (long)i * G + c; if (L >= nwg) return false;
  int wgid = (int)L;
  { const int q = nwg / NXCD, r = nwg % NXCD, xcd = wgid % NXCD, off = wgid / NXCD;
    wgid = (xcd < r ? xcd * (q + 1) : r * (q + 1) + (xcd - r) * q) + off; }
  const int nig = WGM * nN, gid = wgid / nig, fm = gid * WGM, gsz = (nM - fm) < WGM ? (nM - fm) : WGM;
  u.pm = fm + ((wgid % nig) % gsz); u.pn = (wgid % nig) / gsz; return true;
}

enum { EPI_INPROJ = 0, EPI_GLU, EPI_OUTPROJ, EPI_FF1, EPI_FF2, EPI_POOL };

struct GemmDesc {
  const bf16_t* W; int ldw;
  const bf16_t* Act; int lda;
  int K, nN;
  int act_pn_step;
  int a_tstep;
  int a_kstep;
  int kind, layer;
};

DI void gemm_epilogue(PP p, const GemmDesc& d, const f32x4 (&acc)[2][2][4][2], const Unit& u, int wr, int wc, int fr, int fq) {
  const int m0 = u.pm * 256, n0 = u.pn * 256;
  const int tokb = m0 + wr * 64 + fr;
  const int nnb = n0 + wc * 32 + fq * 4;
  const float* modf = (const float*)(p->ws + OFF_MODF);
  switch (d.kind) {
    case EPI_INPROJ: {
      const int region = u.pn >> 1;
      const bool is_lat = m0 >= 4096;
      bf16_t* Qb = (bf16_t*)(p->ws + OFF_Q);
      bf16_t* Kb = (bf16_t*)(p->ws + OFF_K);
      bf16_t* Vf = (bf16_t*)(p->ws + OFF_V);
      float* U = (float*)(p->ws + OFF_U);
      float inv[4];
#pragma unroll
      for (int j = 0; j < 4; ++j) inv[j] = exp2f(-(float)(fq * 4 + j) * 0.8304820237218406f);
#pragma unroll
      for (int ai = 0; ai < 2; ++ai)
#pragma unroll
      for (int m = 0; m < 4; ++m) {
        const int tok = tokb + ai * 128 + m * 16;
        const int lt = (tok - 4096) & 2047;
        const float pos = (wc & 1) ? (float)(lt & 63) : (float)(lt >> 6);
        float cs[4], sn[4];
        if (region < 2 && is_lat) {
#pragma unroll
          for (int j = 0; j < 4; ++j) { float ang = pos * inv[j]; cs[j] = __cosf(ang); sn[j] = __sinf(ang); }
        }
#pragma unroll
        for (int bj = 0; bj < 2; ++bj) {
          f32x4 v[2] = {acc[ai][bj][m][0], acc[ai][bj][m][1]};
          if (region < 2 && is_lat) {
            const f32x4 x1 = v[0], x2 = v[1];
#pragma unroll
            for (int j = 0; j < 4; ++j) { v[0][j] = x1[j] * cs[j] - x2[j] * sn[j]; v[1][j] = x2[j] * cs[j] + x1[j] * sn[j]; }
          }
#pragma unroll
          for (int n = 0; n < 2; ++n) {
            const int nn = nnb + bj * 128 + n * 16;
            const f32x4 vv = v[n];
            if (region == 0) {
              u32x2 o = {pk2(vv[0], vv[1]), pk2(vv[2], vv[3])};
              *(u32x2*)(Qb + (size_t)tok * 512 + nn) = o;
            } else if (region == 1) {
              u32x2 o = {pk2(vv[0], vv[1]), pk2(vv[2], vv[3])};
              {
                const int c = nn - 512, h = c >> 7, mm = (c >> 6) & 1, dd = c & 63;
                int base, l, nkt;
                if (!is_lat) { base = tok & ~255; l = tok & 255; nkt = 8; }
                else { int t2 = tok - 4096; base = 4096 + (t2 >> 11) * 2560; l = t2 & 2047; nkt = 80; }
                *(u32x2*)(Kb + kf_off(base, nkt, h, mm, l >> 5, dd >> 4, 32 * ((dd >> 3) & 1) + (l & 31)) + (dd & 7)) = o;
              }
              if (!is_lat) *(f32x4*)(p->out + OUT_K + (size_t)tok * 512 + (nn - 512)) = vv;
            } else if (region == 2) {
              const int c = nn - 1024, h = c >> 7, dd0 = c & 127;
              int base, l, nkt;
              if (!is_lat) { base = tok & ~255; l = tok & 255; nkt = 8; }
              else { int t2 = tok - 4096; base = 4096 + (t2 >> 11) * 2560; l = t2 & 2047; nkt = 80; }
              const int kt = l >> 5, kk = l & 31, s = kk >> 4, j8 = 4 * ((kk >> 3) & 1) + (kk & 3), hh = (kk >> 2) & 1;
#pragma unroll
              for (int jj = 0; jj < 4; ++jj) {
                int dd = dd0 + jj;
                Vf[vf_off(base, nkt, h, kt, dd >> 5, s, 32 * hh + (dd & 31)) + j8] = f2bf(vv[jj]);
              }
              if (!is_lat) *(f32x4*)(p->out + OUT_V + (size_t)tok * 512 + c) = vv;
            } else {
              *(f32x4*)(U + (size_t)tok * 512 + (nn - 1536)) = vv;
            }
          }
        }
      }
    } break;
    case EPI_GLU: {
      const bf16_t* G = (const bf16_t*)(p->ws + OFF_GS5);
      bf16_t* cat = (bf16_t*)(p->ws + OFF_CAT);
#pragma unroll
      for (int ai = 0; ai < 2; ++ai)
#pragma unroll
      for (int bj = 0; bj < 2; ++bj)
#pragma unroll
      for (int m = 0; m < 4; ++m)
#pragma unroll
      for (int n = 0; n < 2; ++n) {
        const int tok = tokb + ai * 128 + m * 16, nn = nnb + bj * 128 + n * 16;
        const f32x4 v = acc[ai][bj][m][n];
        u32x2 gi = *(const u32x2*)(G + (size_t)tok * 512 + nn);
        float g0 = __uint_as_float(gi[0] << 16), g1 = __uint_as_float(gi[0] & 0xffff0000u);
        float g2 = __uint_as_float(gi[1] << 16), g3 = __uint_as_float(gi[1] & 0xffff0000u);
        u32x2 o = {pk2(g0 / (1.f + __expf(-v[0])), g1 / (1.f + __expf(-v[1]))),
                   pk2(g2 / (1.f + __expf(-v[2])), g3 / (1.f + __expf(-v[3])))};
        *(u32x2*)(cat + (size_t)tok * 1024 + 512 + nn) = o;
      }
    } break;
    case EPI_OUTPROJ: case EPI_FF2: case EPI_POOL: {
      float* X = (float*)(p->ws + OFF_X);
      const int jg = d.kind == EPI_FF2 ? 5 : 2;
      const float* gate = modf + (size_t)((d.layer * 5 + mod_row(m0)) * 6 + jg) * 1024;
#pragma unroll
      for (int ai = 0; ai < 2; ++ai)
#pragma unroll
      for (int bj = 0; bj < 2; ++bj)
#pragma unroll
      for (int m = 0; m < 4; ++m)
#pragma unroll
      for (int n = 0; n < 2; ++n) {
        const int tok = tokb + ai * 128 + m * 16, nn = nnb + bj * 128 + n * 16;
        f32x4 v = acc[ai][bj][m][n];
        f32x4 g = *(const f32x4*)(gate + nn);
        f32x4 xin;
        if (d.kind == EPI_OUTPROJ) {
          const float* xs = tok < 4096 ? p->x_prompt + (size_t)tok * 1024 : p->x_sample + (size_t)(tok - 4096) * 1024;
          xin = __builtin_nontemporal_load((const f32x4*)(xs + nn));
        } else {
          xin = *(const f32x4*)(X + (size_t)tok * 1024 + nn);
        }
        if (d.kind == EPI_POOL) { f32x4 ps = *(const f32x4*)(p->pool_scale + nn); v = v * ps; }
        *(f32x4*)(X + (size_t)tok * 1024 + nn) = xin + g * v;
      }
    } break;
    case EPI_FF1: {
      bf16_t* H = (bf16_t*)(p->ws + OFF_H);
#pragma unroll
      for (int ai = 0; ai < 2; ++ai)
#pragma unroll
      for (int bj = 0; bj < 2; ++bj)
#pragma unroll
      for (int m = 0; m < 4; ++m)
#pragma unroll
      for (int n = 0; n < 2; ++n) {
        const int tok = tokb + ai * 128 + m * 16, nn = nnb + bj * 128 + n * 16;
        f32x4 v = acc[ai][bj][m][n];
        float r0 = fmaxf(v[0], 0.f), r1 = fmaxf(v[1], 0.f), r2 = fmaxf(v[2], 0.f), r3 = fmaxf(v[3], 0.f);
        u32x2 o = {pk2(r0 * r0, r1 * r1), pk2(r2 * r2, r3 * r3)};
        *(u32x2*)(H + ((size_t)((tok >> 8) * 64 + (nn >> 6)) * 256 + (tok & 255)) * 64 + (nn & 63)) = o;
      }
    } break;
  }
}

DI void gemm_phase(PP p, const GemmDesc& d) {
  const int tid = opaque_tid();
  LAS unsigned char* lds = (LAS unsigned char*)g_smem;
  const int wid = __builtin_amdgcn_readfirstlane(tid >> 6), lane = tid & 63, wr = wid >> 2, wc = wid & 3, fr = lane & 15, fq = lane >> 4;
  const int K = d.K, nt = K / BK;
  const int nM = 48, nN = d.nN, G = gridDim.x, cblk = blockIdx.x;
  unsigned voffA[2], voffB[2];
#pragma unroll
  for (int i = 0; i < 2; ++i) { int R, C; stage_rc(tid * 16 + i * 8192, R, C);
    voffA[i] = (unsigned)(R * d.lda + C) * 2u; voffB[i] = (unsigned)(R * d.ldw + C) * 2u; }
  const size_t kstep = (size_t)(BK * 2);
  const size_t kstepA = (size_t)d.a_kstep;
  const size_t hstepA = (size_t)HALF * d.lda * 2, hstepB = (size_t)HALF * d.ldw * 2;
  const size_t tstepA = d.a_tstep ? (size_t)d.a_tstep : 2 * hstepA, tstepB = 2 * hstepB;
  const unsigned ldsw = (unsigned)wid * 1024u;
  const int aoff = lds_byte(wr * 64 + fr, fq * 8), boff = lds_byte(wc * 32 + fr, fq * 8);
#define PG8_SA(b, h) (((b) * 2 + (h)) * HTB)
#define PG8_SB(b, h) ((4 + (b) * 2 + (h)) * HTB)
#define PG8_STAGE(bufoff, gbase, voff) do { _Pragma("unroll") for (int _i = 0; _i < 2; ++_i) \
    __builtin_amdgcn_global_load_lds((const unsigned*)((const char*)(gbase) + (voff)[_i]), (LAS unsigned*)(lds + (bufoff) + ldsw + _i * 8192), 16, 0, 0); } while (0)
#define PG8_LDA(dst, b, h) do { _Pragma("unroll") for (int m = 0; m < 4; ++m) _Pragma("unroll") for (int k = 0; k < 2; ++k) dst[m][k] = *(const LAS bf16x8*)(lds + PG8_SA(b, h) + aoff + m * 2048 + k * 1024); } while (0)
#define PG8_LDB(dst, b, h) do { _Pragma("unroll") for (int n = 0; n < 2; ++n) _Pragma("unroll") for (int k = 0; k < 2; ++k) dst[n][k] = *(const LAS bf16x8*)(lds + PG8_SB(b, h) + boff + n * 2048 + k * 1024); } while (0)
#define PG8_MMA(ai, bj, At, Bt) do { __builtin_amdgcn_s_setprio(1); _Pragma("unroll") for (int m = 0; m < 4; ++m) _Pragma("unroll") for (int n = 0; n < 2; ++n) _Pragma("unroll") for (int k = 0; k < 2; ++k) \
    acc[ai][bj][m][n] = __builtin_amdgcn_mfma_f32_16x16x32_bf16(Bt[n][k], At[m][k], acc[ai][bj][m][n], 0, 0, 0); __builtin_amdgcn_s_setprio(0); } while (0)
#define PG8_WAIT_V(n) asm volatile("s_waitcnt vmcnt(" #n ")" ::: "memory")
#define PG8_WAIT_L(n) asm volatile("s_waitcnt lgkmcnt(" #n ")" ::: "memory")
#define PG8_BAR __builtin_amdgcn_s_barrier()
#define PG8_SCHED __builtin_amdgcn_sched_barrier(0)
  Unit cur, nxt; int ui = 0;
  if (!unit_next(0, nM, nN, G, cblk, cur)) return;
  f32x4 acc[2][2][4][2];
#pragma unroll
  for (int a = 0; a < 2; ++a)
#pragma unroll
    for (int b = 0; b < 2; ++b)
#pragma unroll
      for (int m = 0; m < 4; ++m)
#pragma unroll
        for (int n = 0; n < 2; ++n) acc[a][b][m][n] = (f32x4){0.f, 0.f, 0.f, 0.f};
  bf16x8 At[4][2], B0[2][2], B1[2][2];
  const char* cA = (const char*)d.Act + (size_t)cur.pm * tstepA + (size_t)cur.pn * d.act_pn_step;
  const char* cB = (const char*)d.W + (size_t)cur.pn * tstepB;
  PG8_STAGE(PG8_SB(0, 0), cB, voffB); PG8_STAGE(PG8_SA(0, 0), cA, voffA); PG8_STAGE(PG8_SB(0, 1), cB + hstepB, voffB); PG8_STAGE(PG8_SA(0, 1), cA + hstepA, voffA);
  if (wr == 1) PG8_BAR;
  PG8_WAIT_V(4); PG8_BAR;
  PG8_STAGE(PG8_SB(1, 0), cB + kstep, voffB); PG8_STAGE(PG8_SA(1, 0), cA + kstepA, voffA); PG8_STAGE(PG8_SB(1, 1), cB + hstepB + kstep, voffB);
  PG8_WAIT_V(6); PG8_BAR;
  for (;;) {
    const bool has_next = unit_next(ui + 1, nM, nN, G, cblk, nxt);
    const char* nA = has_next ? (const char*)d.Act + (size_t)nxt.pm * tstepA + (size_t)nxt.pn * d.act_pn_step : cA;
    const char* nB = has_next ? (const char*)d.W + (size_t)nxt.pn * tstepB : cB;
    for (int t = 0; t < nt; t += 2) {
      const bool last = (t == nt - 2);
      const char* a1 = cA + (size_t)(t + 1) * kstepA;
      const char* a2 = last ? nA : cA + (size_t)(t + 2) * kstepA; const char* b2 = last ? nB : cB + (size_t)(t + 2) * kstep;
      const char* a3 = a2 + kstepA; const char* b3 = b2 + kstep;
      PG8_LDB(B0, 0, 0); PG8_SCHED; PG8_LDA(At, 0, 0); PG8_STAGE(PG8_SA(1, 1), a1 + hstepA, voffA);
      PG8_WAIT_L(8); PG8_BAR; PG8_WAIT_L(0); PG8_MMA(0, 0, At, B0); PG8_BAR; PG8_SCHED;
      PG8_LDB(B1, 0, 1); PG8_STAGE(PG8_SB(0, 0), b2, voffB);
      PG8_BAR; PG8_WAIT_L(0); PG8_MMA(0, 1, At, B1); PG8_BAR;
      PG8_LDA(At, 0, 1); PG8_STAGE(PG8_SA(0, 0), a2, voffA);
      PG8_BAR; PG8_WAIT_L(0); PG8_MMA(1, 0, At, B0); PG8_BAR; PG8_SCHED;
      PG8_STAGE(PG8_SB(0, 1), b2 + hstepB, voffB);
      PG8_WAIT_V(6); PG8_BAR; PG8_MMA(1, 1, At, B1); PG8_BAR;
      PG8_LDB(B0, 1, 0); PG8_SCHED; PG8_LDA(At, 1, 0); PG8_STAGE(PG8_SA(0, 1), a2 + hstepA, voffA);
      PG8_WAIT_L(8); PG8_BAR; PG8_WAIT_L(0); PG8_MMA(0, 0, At, B0); PG8_BAR; PG8_SCHED;
      PG8_LDB(B1, 1, 1); PG8_STAGE(PG8_SB(1, 0), b3, voffB);
      PG8_BAR; PG8_WAIT_L(0); PG8_MMA(0, 1, At, B1); PG8_BAR;
      PG8_LDA(At, 1, 1); PG8_STAGE(PG8_SA(1, 0), a3, voffA);
      PG8_BAR; PG8_WAIT_L(0); PG8_MMA(1, 0, At, B0); PG8_BAR; PG8_SCHED;
      PG8_STAGE(PG8_SB(1, 1), b3 + hstepB, voffB);
      PG8_WAIT_V(6); PG8_BAR; PG8_MMA(1, 1, At, B1); PG8_BAR;
    }
    gemm_epilogue(p, d, acc, cur, wr, wc, fr, fq);
    if (!has_next) break;
#pragma unroll
    for (int a = 0; a < 2; ++a)
#pragma unroll
      for (int b = 0; b < 2; ++b)
#pragma unroll
        for (int m = 0; m < 4; ++m)
#pragma unroll
          for (int n = 0; n < 2; ++n) acc[a][b][m][n] = (f32x4){0.f, 0.f, 0.f, 0.f};
    cur = nxt; cA = nA; cB = nB; ++ui;
  }
  PG8_WAIT_V(0);
  if (wr == 0) PG8_BAR;
  PG8_BAR;
}

#define MFMA32(a, b, c) __builtin_amdgcn_mfma_f32_32x32x16_bf16((a), (b), (c), 0, 0, 0)
#define MFMA16(a, b, c) __builtin_amdgcn_mfma_f32_16x16x32_bf16((a), (b), (c), 0, 0, 0)

struct AttnGeom { const bf16_t* qp; const bf16_t* kp; const bf16_t* vp; int qrow; int h; int nkt; };

DI AttnGeom attn_geom(PP p, bool is_lat, int b, int h, int qt, int lane) {
  const int r32 = lane & 31, hh = lane >> 5;
  const bf16_t* Qb = (const bf16_t*)(p->ws + OFF_Q);
  const bf16_t* Kb = (const bf16_t*)(p->ws + OFF_K);
  const bf16_t* Vf = (const bf16_t*)(p->ws + OFF_V);
  int tokbase, kvbase, nkt;
  if (!is_lat) { tokbase = b * 256; kvbase = b * 256; nkt = 8; }
  else { tokbase = 4096 + b * 2048; kvbase = 4096 + b * 2560; nkt = 80; }
  AttnGeom g;
  g.qrow = tokbase + 32 * qt + r32; g.h = h;
  g.qp = Qb + (size_t)g.qrow * 512 + h * 128 + 8 * hh;
  g.kp = Kb + kf_off(kvbase, nkt, h, 0, 0, 0, lane); g.nkt = nkt;
  g.vp = Vf + vf_off(kvbase, nkt, h, 0, 0, 0, lane);
  return g;
}
#define ATT_CS (0.125f * 1.4426950408889634f)
#define EXP2(x) __builtin_amdgcn_exp2f(x)
DI void attn_loadk(bf16x8 (&kc)[2][4], const bf16_t* kq, int nkt) {
#pragma unroll
  for (int m = 0; m < 2; ++m)
#pragma unroll
    for (int s = 0; s < 4; ++s) kc[m][s] = *(const bf16x8*)(kq + (size_t)m * nkt * 2048 + s * 512);
}
DI void attn_pass1(const AttnGeom& g, const bf16x8 (&Qf)[2][4], int kt0, int kt1, float (&mx)[2], float (&ls)[2]) {
  const float cs = ATT_CS;
  bf16x8 kc[2][4];
  attn_loadk(kc, g.kp + (size_t)kt0 * 2048, g.nkt);
#pragma unroll 1
  for (int kt = kt0; kt < kt1; ++kt) {
    f32x16 S[2];
#pragma unroll
    for (int m = 0; m < 2; ++m) {
#pragma unroll
      for (int i = 0; i < 16; ++i) S[m][i] = 0.f;
#pragma unroll
      for (int s = 0; s < 4; ++s) S[m] = MFMA32(kc[m][s], Qf[m][s], S[m]);
    }
    const int ktn = kt + 1 < kt1 ? kt + 1 : kt;
    attn_loadk(kc, g.kp + (size_t)ktn * 2048, g.nkt);
#pragma unroll
    for (int m = 0; m < 2; ++m) {
      float tm = S[m][0];
#pragma unroll
      for (int i = 1; i < 16; ++i) tm = fmaxf(tm, S[m][i]);
      float mn = fmaxf(mx[m], tm);
      float acc = ls[m] * EXP2((mx[m] - mn) * cs);
      float nb = -mn * cs;
#pragma unroll
      for (int i = 0; i < 16; ++i) acc += EXP2(fmaf(S[m][i], cs, nb));
      ls[m] = acc; mx[m] = mn;
    }
  }
}
DI void attn_pass2(const AttnGeom& g, const bf16x8 (&Qf)[2][4], int kt0, int kt1, const float (&nbias)[2], const float (&pscale)[2],
                   f32x16 (&O)[4]) {
  const float cs = ATT_CS;
  bf16x8 kc[2][4];
  attn_loadk(kc, g.kp + (size_t)kt0 * 2048, g.nkt);
#pragma unroll 1
  for (int kt = kt0; kt < kt1; ++kt) {
    const bf16_t* vq = g.vp + (size_t)kt * 4096;
    bf16x8 vf[8];
#pragma unroll
    for (int i = 0; i < 8; ++i) vf[i] = *(const bf16x8*)(vq + i * 512);
    f32x16 S0, S1;
#pragma unroll
    for (int i = 0; i < 16; ++i) { S0[i] = 0.f; S1[i] = 0.f; }
#pragma unroll
    for (int s = 0; s < 4; ++s) { S0 = MFMA32(kc[0][s], Qf[0][s], S0); S1 = MFMA32(kc[1][s], Qf[1][s], S1); }
    const int ktn = kt + 1 < kt1 ? kt + 1 : kt;
    attn_loadk(kc, g.kp + (size_t)ktn * 2048, g.nkt);
    float w[16];
#pragma unroll
    for (int i = 0; i < 16; ++i)
      w[i] = EXP2(fmaf(S0[i], cs, nbias[0])) * pscale[0] - EXP2(fmaf(S1[i], cs, nbias[1])) * pscale[1];
#pragma unroll
    for (int s = 0; s < 2; ++s) {
      u32x4 pw = {pk2(w[8 * s], w[8 * s + 1]), pk2(w[8 * s + 2], w[8 * s + 3]),
                  pk2(w[8 * s + 4], w[8 * s + 5]), pk2(w[8 * s + 6], w[8 * s + 7])};
      bf16x8 wf = __builtin_bit_cast(bf16x8, pw);
#pragma unroll
      for (int dt = 0; dt < 4; ++dt) O[dt] = MFMA32(vf[dt * 2 + s], wf, O[dt]);
    }
  }
}
DI void attn_finish(PP p, const AttnGeom& g, const f32x16 (&O)[4], int lane) {
  const int hh = lane >> 5;
  bf16_t* cat = (bf16_t*)(p->ws + OFF_CAT);
  float ss = 0.f;
#pragma unroll
  for (int dt = 0; dt < 4; ++dt)
#pragma unroll
    for (int i = 0; i < 16; ++i) ss += O[dt][i] * O[dt][i];
  ss += __shfl_xor(ss, 32);
  const float rstd = rsqrtf(ss * (1.f / 128.f) + 1e-6f) * 0.8f;
#pragma unroll
  for (int dt = 0; dt < 4; ++dt)
#pragma unroll
    for (int i4 = 0; i4 < 4; ++i4) {
      const int d0 = 32 * dt + 8 * i4 + 4 * hh;
      f32x4 gg = *(const f32x4*)(p->subln_g + d0);
      u32x2 o = {pk2(O[dt][4 * i4] * rstd * gg[0], O[dt][4 * i4 + 1] * rstd * gg[1]),
                 pk2(O[dt][4 * i4 + 2] * rstd * gg[2], O[dt][4 * i4 + 3] * rstd * gg[3])};
      *(u32x2*)(cat + (size_t)g.qrow * 1024 + g.h * 128 + d0) = o;
    }
}
DI void attn_loadq(const AttnGeom& g, bf16x8 (&Qf)[2][4]) {
#pragma unroll
  for (int m = 0; m < 2; ++m)
#pragma unroll
    for (int s = 0; s < 4; ++s) Qf[m][s] = *(const bf16x8*)(g.qp + m * 64 + 16 * s);
}

DI void attn_item_solo(PP p, int b, int h, int qt, float lam, const int tid) {
  const int lane = tid & 63;
  const AttnGeom g = attn_geom(p, false, b, h, qt, lane);
  bf16x8 Qf[2][4];
  attn_loadq(g, Qf);
  const float cs = ATT_CS;
  float mx[2] = {-1e30f, -1e30f}, ls[2] = {0.f, 0.f};
  attn_pass1(g, Qf, 0, 8, mx, ls);
  float nbias[2], pscale[2];
#pragma unroll
  for (int m = 0; m < 2; ++m) {
    float mo = __shfl_xor(mx[m], 32), lo = __shfl_xor(ls[m], 32);
    float M = fmaxf(mx[m], mo);
    float L = ls[m] * EXP2((mx[m] - M) * cs) + lo * EXP2((mo - M) * cs);
    nbias[m] = -M * cs;
    pscale[m] = (m == 0 ? 1.f : lam) / L;
  }
  f32x16 O[4];
#pragma unroll
  for (int dt = 0; dt < 4; ++dt)
#pragma unroll
    for (int i = 0; i < 16; ++i) O[dt][i] = 0.f;
  attn_pass2(g, Qf, 0, 8, nbias, pscale, O);
  attn_finish(p, g, O, lane);
}

#define ATT_STAGE 32768
#define ATT_WAITV(n) asm volatile("s_waitcnt vmcnt(" #n ")" ::: "memory")
#define ATT_BAR do { asm volatile("" ::: "memory"); __builtin_amdgcn_s_barrier(); asm volatile("" ::: "memory"); } while (0)
template <bool WITHV>
DI void attn_stage_issue(const bf16_t* kbh, const bf16_t* vbh, int t, int stage, int tid, LAS unsigned char* lds) {
  const int lane = tid & 63, wv = __builtin_amdgcn_readfirstlane(tid >> 6);
#pragma unroll
  for (int kh = 0; kh < 2; ++kh) {
    const int kt = kh * 40 + t;
    const bf16_t* ksrc = kbh + ((size_t)(((wv >> 2) * 80 + kt) * 4 + (wv & 3))) * 512 + lane * 8;
    __builtin_amdgcn_global_load_lds((const unsigned*)ksrc, (LAS unsigned*)(lds + stage * ATT_STAGE + kh * 16384 + wv * 1024), 16, 0, 0);
    if (WITHV) {
      const bf16_t* vsrc = vbh + (size_t)kt * 4096 + tid * 8;
      __builtin_amdgcn_global_load_lds((const unsigned*)vsrc, (LAS unsigned*)(lds + stage * ATT_STAGE + kh * 16384 + 8192 + wv * 1024), 16, 0, 0);
    }
  }
}

DI void attn_stage_issue2(const bf16_t* kbh, const bf16_t* vbh, int T, int stage, int tid, LAS unsigned char* lds) {
  const int lane = tid & 63, wv = __builtin_amdgcn_readfirstlane(tid >> 6);
#pragma unroll
  for (int j = 0; j < 2; ++j) {
    const int kt = 2 * T + j;
    const bf16_t* ksrc = kbh + ((size_t)(((wv >> 2) * 80 + kt) * 4 + (wv & 3))) * 512 + lane * 8;
    __builtin_amdgcn_global_load_lds((const unsigned*)ksrc, (LAS unsigned*)(lds + stage * ATT_STAGE + j * 16384 + wv * 1024), 16, 0, 0);
    const bf16_t* vsrc = vbh + (size_t)kt * 4096 + tid * 8;
    __builtin_amdgcn_global_load_lds((const unsigned*)vsrc, (LAS unsigned*)(lds + stage * ATT_STAGE + j * 16384 + 8192 + wv * 1024), 16, 0, 0);
  }
}

DI void attn_block(PP p, int base_item, float lam, const int tid) {
  LAS unsigned char* lds = (LAS unsigned char*)g_smem;
  const int lane = tid & 63, wid = __builtin_amdgcn_readfirstlane(tid >> 6), mp = wid & 1;
  const int item = base_item + (wid >> 1);
  const int b = item >> 8, h = (item >> 6) & 3;
  const AttnGeom g = attn_geom(p, true, b, h, item & 63, lane);
  const int kvbase = 4096 + b * 2560;
  const bf16_t* kbh = (const bf16_t*)(p->ws + OFF_K) + kf_off(kvbase, 80, h, 0, 0, 0, 0);
  const bf16_t* vbh = (const bf16_t*)(p->ws + OFF_V) + vf_off(kvbase, 80, h, 0, 0, 0, 0);
  float* odump = (float*)(g_smem + (wid >> 1) * 16384);
  bf16x8 Qf[4];
#pragma unroll
  for (int s = 0; s < 4; ++s) Qf[s] = *(const bf16x8*)(g.qp + mp * 64 + 16 * s);
  const float cs = ATT_CS;
  const float TAU = 8.0f / ATT_CS;
  const unsigned rdK = mp * 4096 + lane * 16, rdV = 8192 + lane * 16;
  float mrun = -1e30f, lsum = 0.f;
  f32x16 O[4];
#pragma unroll
  for (int dt = 0; dt < 4; ++dt)
#pragma unroll
    for (int i = 0; i < 16; ++i) O[dt][i] = 0.f;
#define MS_QK(SLOTP, DST) do { _Pragma("unroll") for (int i_ = 0; i_ < 16; ++i_) DST[i_] = 0.f; \
    _Pragma("unroll") for (int s_ = 0; s_ < 4; ++s_) DST = MFMA32(*(const LAS bf16x8*)((SLOTP) + rdK + s_ * 1024), Qf[s_], DST); } while (0)
#define MS_SOFTMAX(S) do { \
    float tm_ = S[0]; _Pragma("unroll") for (int i_ = 1; i_ < 16; ++i_) tm_ = fmaxf(tm_, S[i_]); \
    { auto sw_ = __builtin_amdgcn_permlane32_swap(__float_as_uint(tm_), __float_as_uint(tm_), false, false); tm_ = fmaxf(__uint_as_float(sw_[0]), __uint_as_float(sw_[1])); } \
    if (__any(tm_ > mrun + TAU)) { const float mn_ = fmaxf(mrun, tm_); const float al_ = EXP2((mrun - mn_) * cs); lsum *= al_; \
      _Pragma("unroll") for (int dt_ = 0; dt_ < 4; ++dt_) _Pragma("unroll") for (int i_ = 0; i_ < 16; ++i_) O[dt_][i_] *= al_; mrun = mn_; } \
    const float nb_ = -mrun * cs; float ac_ = 0.f; \
    _Pragma("unroll") for (int i_ = 0; i_ < 16; ++i_) { S[i_] = EXP2(fmaf(S[i_], cs, nb_)); ac_ += S[i_]; } \
    lsum += ac_; \
    _Pragma("unroll") for (int s_ = 0; s_ < 2; ++s_) { \
      u32x4 pw_ = {pk2(S[8 * s_], S[8 * s_ + 1]), pk2(S[8 * s_ + 2], S[8 * s_ + 3]), pk2(S[8 * s_ + 4], S[8 * s_ + 5]), pk2(S[8 * s_ + 6], S[8 * s_ + 7])}; \
      P[s_] = __builtin_bit_cast(bf16x8, pw_); } } while (0)
#define MS_PV(SLOTP) do { _Pragma("unroll") for (int s_ = 0; s_ < 2; ++s_) _Pragma("unroll") for (int dt_ = 0; dt_ < 4; ++dt_) \
    O[dt_] = MFMA32(*(const LAS bf16x8*)((SLOTP) + rdV + (dt_ * 2 + s_) * 1024), P[s_], O[dt_]); } while (0)
  ATT_BAR;
  attn_stage_issue2(kbh, vbh, 0, 0, tid, lds);
  attn_stage_issue2(kbh, vbh, 1, 1, tid, lds);
  attn_stage_issue2(kbh, vbh, 2, 2, tid, lds);
  ATT_WAITV(8);
  ATT_BAR;
  f32x16 Sa, Sb;
  MS_QK(lds, Sa);
#pragma unroll 1
  for (int T = 0; T < 40; ++T) {
    const LAS unsigned char* stc = lds + (T & 3) * ATT_STAGE;
    const LAS unsigned char* stn = lds + ((T + 1) & 3) * ATT_STAGE;
    if (T + 1 < 40) {
      if (T + 2 < 40) ATT_WAITV(4); else ATT_WAITV(0);
      ATT_BAR;
      if (T + 3 < 40) attn_stage_issue2(kbh, vbh, T + 3, (T + 3) & 3, tid, lds);
    }
    bf16x8 P[2];
    MS_QK(stc + 16384, Sb);
    MS_SOFTMAX(Sa);
    MS_PV(stc);
    if (T + 1 < 40) MS_QK(stn, Sa);
    MS_SOFTMAX(Sb);
    MS_PV(stc + 16384);
  }
  { auto sw_ = __builtin_amdgcn_permlane32_swap(__float_as_uint(lsum), __float_as_uint(lsum), false, false); lsum = __uint_as_float(sw_[0]) + __uint_as_float(sw_[1]); }
  const float sc = (mp == 0 ? 1.f : lam) / lsum;
  asm volatile("s_waitcnt lgkmcnt(0)" ::: "memory");
  ATT_BAR;
  if (mp) {
#pragma unroll
    for (int dt = 0; dt < 4; ++dt)
#pragma unroll
      for (int i = 0; i < 16; ++i) odump[(dt * 16 + i) * 64 + lane] = O[dt][i] * sc;
  }
  asm volatile("s_waitcnt lgkmcnt(0)" ::: "memory");
  ATT_BAR;
  if (!mp) {
#pragma unroll
    for (int dt = 0; dt < 4; ++dt)
#pragma unroll
      for (int i = 0; i < 16; ++i) O[dt][i] = O[dt][i] * sc - odump[(dt * 16 + i) * 64 + lane];
    attn_finish(p, g, O, lane);
  }
  asm volatile("s_waitcnt lgkmcnt(0)" ::: "memory");
  ATT_BAR;
}

constexpr int S5_BU_STRIDE = 132;
constexpr int S5_H_STRIDE = 136;
constexpr int S5_ROWS = 64;
constexpr int S5_WAVE_LDS = S5_ROWS * S5_H_STRIDE * 2;

DI float gelu_tanh(float x) {
  float z = 0.7978845608028654f * (x + 0.044715f * x * x * x);
  float e = __expf(2.f * z);
  float t = 1.f - 2.f / (e + 1.f);
  return 0.5f * x * (1.f + t);
}

template <bool FULL>
DI void s5_task(PP p, int gc, int g, const int tid) {
  const int lane = tid & 63, wid = tid >> 6, fr = lane & 15, fq = lane >> 4;
  bf16_t* Hs = (bf16_t*)(g_smem + wid * S5_WAVE_LDS);
  const float* U = (const float*)(p->ws + OFF_U);
  float* E = (float*)(p->ws + OFF_E);
  const bool is_lat = gc >= 64;
  int seqb, c, nc, gcbase;
  if (!is_lat) { seqb = gc >> 2; c = gc & 3; nc = 4; gcbase = gc & ~3; }
  else { seqb = (gc - 64) >> 5; c = (gc - 64) & 31; nc = 32; gcbase = 64 + ((gc - 64) & ~31); }
  const int t0 = gc * 64;
  f32x4 yacc[4];
#pragma unroll
  for (int i = 0; i < 4; ++i) yacc[i] = f32x4{0.f, 0.f, 0.f, 0.f};
  u32x4 ufa[4];
#pragma unroll
  for (int sc = 0; sc < 4; ++sc) {
    ufa[sc] = u32x4{0, 0, 0, 0};
    if (fq < 2) {
      const float* up = U + (size_t)(t0 + 16 * sc + fr) * 512 + 16 * g + 8 * fq;
      float4 v0 = *(const float4*)up, v1 = *(const float4*)(up + 4);
      ufa[sc] = u32x4{pk2(v0.x, v0.y), pk2(v0.z, v0.w), pk2(v1.x, v1.y), pk2(v1.z, v1.w)};
    }
  }

  float4 av2[2]; bf16x8 Bf2[2][8]; bf16x8 Cf2[2][4];
#pragma unroll
  for (int d2 = 0; d2 < 2; ++d2) {
    av2[d2] = ((const float4*)(p->ws + OFF_S5TA))[(d2 * 32 + g) * 64 + lane];
    const u32x4* tb = (const u32x4*)(p->ws + OFF_S5TB) + (size_t)((d2 * 32 + g) * 8) * 64 + lane;
#pragma unroll
    for (int nt = 0; nt < 8; ++nt) Bf2[d2][nt] = __builtin_bit_cast(bf16x8, tb[nt * 64]);
    if (FULL) {
      const u32x4* tc = (const u32x4*)(p->ws + OFF_S5TC) + (size_t)((d2 * 32 + g) * 4) * 64 + lane;
#pragma unroll
      for (int ks = 0; ks < 4; ++ks) Cf2[d2][ks] = __builtin_bit_cast(bf16x8, tc[ks * 64]);
    }
  }
#pragma unroll
  for (int dr = 0; dr < 2; ++dr) {
    const float4 av = av2[dr];
    const float a_re = av.x, a_im = av.y;
    float hre = 0.f, him = 0.f;
    if (FULL) {
      const float A64r = av.z, A64i = av.w;
      if (is_lat) {
        const float* h0 = p->state_s5 + ((size_t)((seqb * 2 + dr) * 32 + g) * 64 + lane) * 2;
        hre = h0[0]; him = h0[1];
      }
      {
        const int cnt = dr == 0 ? c : nc - 1 - c;
        const int j0 = dr == 0 ? gcbase : gcbase + nc - 1, js = dr == 0 ? 1 : -1;
        const float2* Eb = (const float2*)E + ((size_t)g * 2 + dr) * 64 + lane;
        for (int q0 = 0; q0 < cnt; q0 += 16) {
          float2 ev[16];
#pragma unroll
          for (int q = 0; q < 16; ++q) {
            const int jj = q0 + q < cnt ? j0 + js * (q0 + q) : j0;
            ev[q] = Eb[(size_t)jj * (32 * 2 * 64)];
          }
#pragma unroll
          for (int q = 0; q < 16; ++q) {
            if (q0 + q < cnt) {
              float tr, ti; cmul(A64r, A64i, hre, him, tr, ti);
              hre = tr + ev[q].x; him = ti + ev[q].y;
            }
          }
        }
      }
    }
    const bf16x8 (&Bf)[8] = Bf2[dr];
    const bf16x8 (&Cf)[4] = Cf2[dr];
    bf16_t* BH = Hs;
    wave_lds_sync();
#pragma unroll
    for (int tile = 0; tile < 4; ++tile) {
      const bf16x8 ufr = __builtin_bit_cast(bf16x8, ufa[tile]);
#pragma unroll
      for (int nt = 0; nt < 8; ++nt) {
        f32x4 z = {0.f, 0.f, 0.f, 0.f};
        f32x4 d = MFMA16(Bf[nt], ufr, z);
        u32x2 o = {pk2(d[0], d[1]), pk2(d[2], d[3])};
        *(u32x2*)(BH + (16 * tile + fr) * S5_H_STRIDE + 16 * nt + 4 * fq) = o;
      }
    }
    wave_lds_sync();
#pragma unroll 1
    for (int hh = 0; hh < 4; ++hh) {
      const int tile = dr == 0 ? hh : 3 - hh;
      float bre[16], bim[16];
#pragma unroll
      for (int t = 0; t < 16; ++t) { bre[t] = bf2f(BH[(16 * tile + t) * S5_H_STRIDE + lane]); bim[t] = bf2f(BH[(16 * tile + t) * S5_H_STRIDE + 64 + lane]); }
      asm volatile("s_waitcnt lgkmcnt(0)" ::: "memory");
      __builtin_amdgcn_wave_barrier();
      if (dr == 1) {
#pragma unroll
        for (int t = 0; t < 8; ++t) { float x = bre[t]; bre[t] = bre[15 - t]; bre[15 - t] = x; x = bim[t]; bim[t] = bim[15 - t]; bim[15 - t] = x; }
      }
      const int tsgn = dr == 0 ? 1 : -1, tbase = 16 * tile + (dr == 0 ? 0 : 15);
#pragma unroll
      for (int tt = 0; tt < 16; ++tt) {
        const int t = tbase + tsgn * tt;
        const float nre = fmaf(-a_im, him, fmaf(a_re, hre, bre[tt]));
        const float nim = fmaf(a_im, hre, fmaf(a_re, him, bim[tt]));
        hre = nre; him = nim;
        if (FULL) { BH[t * S5_H_STRIDE + lane] = f2bf(nre); BH[t * S5_H_STRIDE + 64 + lane] = f2bf(nim); }
      }
      asm volatile("" ::: "memory");
    }
    if (FULL) {
      wave_lds_sync();
#pragma unroll
      for (int tile = 0; tile < 4; ++tile)
#pragma unroll
        for (int ks = 0; ks < 4; ++ks) {
          bf16x8 hf = *(const bf16x8*)(BH + (16 * tile + fr) * S5_H_STRIDE + 32 * ks + 8 * fq);
          yacc[tile] = MFMA16(Cf[ks], hf, yacc[tile]);
        }
    }
    if (!FULL) {
      float* e = E + ((size_t)((gc * 32 + g) * 2 + dr) * 64 + lane) * 2;
      e[0] = hre; e[1] = him;
    } else if (!is_lat) {
      if ((dr == 0 && c == nc - 1) || (dr == 1 && c == 0)) {
        float* o = p->out + OUT_S + ((size_t)((seqb * 2 + dr) * 32 + g) * 64 + lane) * 2;
        o[0] = hre; o[1] = him;
      }
    }
  }
  if (FULL) {
    bf16_t* G = (bf16_t*)(p->ws + OFF_GS5);
    const f32x4 dsk = *(const f32x4*)(p->s5_d + 16 * g + 4 * fq);
#pragma unroll
    for (int sc = 0; sc < 4; ++sc) {
      const int tok = t0 + 16 * sc + fr;
      const f32x4 u = *(const f32x4*)(U + (size_t)tok * 512 + 16 * g + 4 * fq);
      f32x4 y = yacc[sc] + dsk * u;
      u32x2 o = {pk2(gelu_tanh(y[0]), gelu_tanh(y[1])), pk2(gelu_tanh(y[2]), gelu_tanh(y[3]))};
      *(u32x2*)(G + (size_t)tok * 512 + 16 * g + 4 * fq) = o;
    }
  }
}

DI void phase_attn_s5a(PP p, int part) {
  const int tid = opaque_tid();
  const int lane = tid & 63, wid = tid >> 6;
  float v1 = p->dl_qk[lane] * p->dl_qk[64 + lane], v2 = p->dl_qk[128 + lane] * p->dl_qk[192 + lane];
  v1 = wave_sum(v1); v2 = wave_sum(v2);
  const float lam = __uint_as_float((unsigned)__builtin_amdgcn_readfirstlane((int)__float_as_uint(expf(v1) - expf(v2) + 0.2f)));
  if (part != 2)
  {
    const int G = gridDim.x;
    const int lb = (G & 7) == 0 ? (blockIdx.x & 7) * (G >> 3) + (blockIdx.x >> 3) : blockIdx.x;
    for (int base = lb * 4; base < 1024; base += G * 4) attn_block(p, base, lam, tid);
  }
  if (part == 1) return;
  {
    const int tid2 = opaque_tid();
    const int lane2 = tid2 & 63;
    volatile unsigned* ctr = (volatile unsigned*)(g_smem + LDS_ST_OFF + 32);
    if (tid2 == 0) *ctr = 0u;
    __syncthreads();
    for (;;) {
      unsigned k = 0;
      if (lane2 == 0) k = atomicAdd((unsigned*)ctr, 1u);
      k = (unsigned)__builtin_amdgcn_readfirstlane((int)k);
      const int j = blockIdx.x + (int)k * gridDim.x;
      if (j >= 512 + 6144) break;
      if (j < 512) attn_item_solo(p, j >> 5, (j >> 3) & 3, j & 7, lam, tid2);
      else { int tsk = j - 512; s5_task<false>(p, tsk >> 5, tsk & 31, tid2); }
    }
  }
}
DI void phase_s5c(PP p) {
  const int tid = opaque_tid();
  const int wid = tid >> 6;
  const int nW = gridDim.x * 8, gw = blockIdx.x * 8 + wid;
  for (int tsk = gw; tsk < 6144; tsk += nW) s5_task<true>(p, tsk >> 5, tsk & 31, tid);
}

#define XB_TMO      128
#define XB_XCNT(j)  (256  + 64 * (j))
#define XB_XSUB(j)  (1280 + 64 * (j))
#define XB_XGEN(j)  (2304 + 64 * (j))
#define XB_TOP      3328
#define XB_TOPGEN   3392
#define XCD_BAR_WORDS 3456
#define XB_SPIN_CAP (1u << 18)
#define XLAS __attribute__((address_space(3)))
DI unsigned xb_ld(unsigned* p)              { return __hip_atomic_load(p, __ATOMIC_RELAXED, __HIP_MEMORY_SCOPE_AGENT); }
DI unsigned xb_add(unsigned* p, unsigned v) { return __hip_atomic_fetch_add(p, v, __ATOMIC_RELAXED, __HIP_MEMORY_SCOPE_AGENT); }
DI unsigned xb_xcc_id() { return (unsigned)__builtin_amdgcn_s_getreg((3 << 11) | 20) & 0xFu; }
#define XB_SPIN(cond, bar) do { unsigned _sp = 0; while (cond) { __builtin_amdgcn_s_sleep(1); \
    if ((++_sp & 255u) == 0u) { if (xb_ld(&(bar)[XB_TMO])) break; if (_sp > XB_SPIN_CAP) { atomicAdd(&(bar)[XB_TMO], 1u); break; } } } } while (0)
struct XcdBarrier { unsigned* bar; unsigned x; volatile XLAS unsigned* st; };
DI XcdBarrier xcd_barrier_post(unsigned* bar, volatile XLAS unsigned* st) {
  XcdBarrier b; b.bar = bar; b.x = xb_xcc_id(); b.st = st;
  if (threadIdx.x == 0) (void)xb_add(&bar[XB_XCNT(b.x)], 1u);
  return b;
}
DI void xcd_barrier_complete(unsigned* bar, unsigned x, unsigned& nloc, unsigned& nx) {
  const unsigned G = gridDim.x * gridDim.y * gridDim.z;
  unsigned sum, cnt, mine, sp = 0u;
  for (;;) {
    sum = 0u; cnt = 0u; mine = 0u;
#pragma unroll
    for (unsigned j = 0; j < 16; ++j) { const unsigned c = xb_ld(&bar[XB_XCNT(j)]); sum += c; cnt += (c > 0u) ? 1u : 0u; mine = (j == x) ? c : mine; }
    if (sum == G) break;
    __builtin_amdgcn_s_sleep(1);
    if ((++sp & 255u) == 0u) { if (xb_ld(&bar[XB_TMO])) break; if (sp > XB_SPIN_CAP) { atomicAdd(&bar[XB_TMO], 1u); break; } }
  }
  nloc = mine > 0u ? mine : 1u; nx = cnt > 0u ? cnt : 1u;
}
DI void xcd_barrier(const XcdBarrier& b) {
  asm volatile("s_waitcnt vmcnt(0)" ::: "memory");
  __syncthreads();
  if (threadIdx.x == 0) {
    unsigned* bar = b.bar;
    __builtin_amdgcn_s_waitcnt(0);
    unsigned nloc = b.st[0], nx = b.st[1];
    if (nloc == 0u) { xcd_barrier_complete(bar, b.x, nloc, nx); b.st[0] = nloc; b.st[1] = nx; }
    const unsigned old = xb_add(&bar[XB_XSUB(b.x)], 1u);
    const unsigned gen = old / nloc;
    if (old + 1u == (gen + 1u) * nloc) {
      __builtin_amdgcn_fence(__ATOMIC_RELEASE, "agent");
      asm volatile("s_waitcnt vmcnt(0)" ::: "memory");
      const unsigned og = xb_add(&bar[XB_TOP], 1u);
      const unsigned tg = og / nx;
      if (og + 1u == (tg + 1u) * nx) xb_add(&bar[XB_TOPGEN], 1u);
      else XB_SPIN(xb_ld(&bar[XB_TOPGEN]) == tg, bar);
      __builtin_amdgcn_fence(__ATOMIC_ACQUIRE, "agent");
      xb_add(&bar[XB_XGEN(b.x)], 1u);
      asm volatile("s_waitcnt vmcnt(0)" ::: "memory");
    } else {
      XB_SPIN(xb_ld(&bar[XB_XGEN(b.x)]) == gen, bar);
      __builtin_amdgcn_fence(__ATOMIC_ACQUIRE, "agent");
      asm volatile("s_waitcnt vmcnt(0)" ::: "memory");
    }
  }
  __syncthreads();
}

constexpr int N_PHASES = 18;
#define PANEL_CNT_WORD0 3584
#define NORM_FUSED (gridDim.x >= 192u)
#ifndef REP_PHASE
#define REP_PHASE -1
#endif
#ifndef REP_PART
#define REP_PART 0
#endif

template <int PH>
DI void run_phase() {
  const int rep = 0;
    PP p = get_pp();
    const float* Xw = (const float*)(p->ws + OFF_X);
    GemmDesc d;
    d.act_pn_step = 0; d.a_kstep = 128; d.a_tstep = 0; d.kind = -1; d.layer = 0;
    d.W = nullptr; d.Act = nullptr; d.ldw = 0; d.lda = 0; d.K = 0; d.nN = 0;
    switch (PH) {
      case 0: phase_mod_partial(p); break;
      case 1: phase_prep(p, 0, blockIdx.x, gridDim.x); break;
      case 2: phase_norm(p, p->x_prompt, p->x_sample, 0, 0, 0); break;
      case 3: d.W = (const bf16_t*)(p->ws + OFF_WIN); d.ldw = 1024; d.Act = (const bf16_t*)(p->ws + OFF_HN); d.lda = 1024;
              d.K = 1024; d.nN = 8; d.kind = EPI_INPROJ; d.layer = 0; break;
#ifndef NO_P4
      case 4: phase_attn_s5a(p, 0); break;
#endif
#ifndef NO_P5
      case 5: phase_s5c(p); break;
#endif
      case 6: d.W = (const bf16_t*)(p->ws + OFF_WGLU); d.ldw = 512; d.Act = (const bf16_t*)(p->ws + OFF_GS5); d.lda = 512;
              d.K = 512; d.nN = 2; d.kind = EPI_GLU; break;
      case 7: d.W = (const bf16_t*)(p->ws + OFF_WOUT); d.ldw = 1024; d.Act = (const bf16_t*)(p->ws + OFF_CAT); d.lda = 1024;
              d.K = 1024; d.nN = 4; d.kind = EPI_OUTPROJ; d.layer = 0; break;
      case 8: if (!NORM_FUSED) phase_norm(p, Xw, Xw + 4096ull * 1024, 0, 3, 0); break;
      case 9: d.W = (const bf16_t*)(p->ws + OFF_W1); d.ldw = 1024; d.Act = (const bf16_t*)(p->ws + OFF_HN); d.lda = 1024;
              d.K = 1024; d.nN = 16; d.kind = EPI_FF1; break;
      case 10: d.W = (const bf16_t*)(p->ws + OFF_W2); d.ldw = 4096; d.Act = (const bf16_t*)(p->ws + OFF_H); d.lda = 64; d.a_kstep = 32768; d.a_tstep = 2097152;
               d.K = 4096; d.nN = 4; d.kind = EPI_FF2; d.layer = 0; break;
      case 11: if (!NORM_FUSED) phase_norm(p, Xw, Xw + 4096ull * 1024, 1, 0, 1); break;
      case 12: phase_pool_z(p); break;
      case 13: d.W = (const bf16_t*)(p->ws + OFF_WPOOL); d.ldw = 256; d.Act = (const bf16_t*)(p->ws + OFF_HN); d.lda = 1024;
               d.K = 256; d.nN = 4; d.act_pn_step = 512; d.kind = EPI_POOL; d.layer = 1; break;
      case 14: if (!NORM_FUSED) phase_norm(p, Xw, Xw + 4096ull * 1024, 1, 3, 0); break;
      case 15: d.W = (const bf16_t*)(p->ws + OFF_W1) + 4194304ull; d.ldw = 1024; d.Act = (const bf16_t*)(p->ws + OFF_HN); d.lda = 1024;
               d.K = 1024; d.nN = 16; d.kind = EPI_FF1; break;
      case 16: d.W = (const bf16_t*)(p->ws + OFF_W2) + 4194304ull; d.ldw = 4096; d.Act = (const bf16_t*)(p->ws + OFF_H); d.lda = 64; d.a_kstep = 32768; d.a_tstep = 2097152;
               d.K = 4096; d.nN = 4; d.kind = EPI_FF2; d.layer = 1; break;
      case 17: if (!NORM_FUSED) phase_norm(p, Xw, Xw + 4096ull * 1024, 0, 0, 2); break;
    }
#ifndef NO_GEMM
    if (d.kind >= 0) gemm_phase(p, d);
#endif
    if ((PH == 7 || PH == 10 || PH == 13 || PH == 16) && NORM_FUSED) {
      Unit u;
      if (unit_next(0, 48, 4, gridDim.x, blockIdx.x, u)) {
        const int slot = PH == 7 ? 0 : PH == 10 ? 1 : PH == 13 ? 2 : 3;
        unsigned* cnt = (unsigned*)(p->ws + OFF_BAR) + PANEL_CNT_WORD0 + slot * 64 + u.pm;
        if (threadIdx.x == 0) {
          __builtin_amdgcn_fence(__ATOMIC_RELEASE, "agent");
          asm volatile("s_waitcnt vmcnt(0)" ::: "memory");
          (void)xb_add(cnt, 1u);
          unsigned spins = 0;
          while (xb_ld(cnt) < 4u) { __builtin_amdgcn_s_sleep(2); if (++spins > (1u << 22)) break; }
          __builtin_amdgcn_fence(__ATOMIC_ACQUIRE, "agent");
          asm volatile("s_waitcnt vmcnt(0)" ::: "memory");
        }
        __syncthreads();
        const int rb = u.pm * 256 + u.pn * 64;
        const int wv = (int)(threadIdx.x >> 6);
        if (PH == 7)  phase_norm(p, Xw, Xw + 4096ull * 1024, 0, 3, 0, rb, rb + 64, wv, 8);
        if (PH == 10) phase_norm(p, Xw, Xw + 4096ull * 1024, 1, 0, 1, rb, rb + 64, wv, 8);
        if (PH == 13) phase_norm(p, Xw, Xw + 4096ull * 1024, 1, 3, 0, rb, rb + 64, wv, 8);
        if (PH == 16) phase_norm(p, Xw, Xw + 4096ull * 1024, 0, 0, 2, rb, rb + 64, wv, 8);
      }
    }
    if (rep == 0) {
      if (PH == 3) {
        const int first = gridDim.x >> 1, nb = gridDim.x - first;
        if ((int)blockIdx.x >= first) {
          const int tid = opaque_tid();
          const int bid = blockIdx.x - first;
          for (int it = bid; it < 512; it += nb) transpose_item(p, it < 256 ? 224 + it : 736 + (it - 256), tid);
          phase_prep(p, 1, bid, nb);
        }
      }
      if (PH == 10) {
        const int first = (gridDim.x * 3) >> 2, nb = gridDim.x - first;
        if ((int)blockIdx.x >= first) {
          const int tid = opaque_tid();
          for (int it = blockIdx.x - first; it < 512; it += nb) transpose_item(p, it < 256 ? 480 + it : 992 + (it - 256), tid);
        }
      }
    }
}
template <int PH>
DI void run_from(cg::grid_group& grid) {
  if constexpr (PH < N_PHASES) {
    if constexpr (PH > 0) {
      XcdBarrier xb; xb.bar = (unsigned*)(get_pp()->ws + OFF_BAR); xb.x = xb_xcc_id();
      xb.st = (volatile XLAS unsigned*)((XLAS unsigned char*)g_smem + LDS_ST_OFF);
      if constexpr (PH == 1) { grid.sync(); if (threadIdx.x == 0) (void)xb_add(&xb.bar[XB_XCNT(xb.x)], 1u); }
      else if (!((PH == 8 || PH == 11 || PH == 14 || PH == 17) && NORM_FUSED)) xcd_barrier(xb);
    }
    if constexpr (PH == REP_PHASE && PH >= 2) {
      run_phase<PH>();
      XcdBarrier xb2; xb2.bar = (unsigned*)(get_pp()->ws + OFF_BAR); xb2.x = xb_xcc_id();
      xb2.st = (volatile XLAS unsigned*)((XLAS unsigned char*)g_smem + LDS_ST_OFF);
      xcd_barrier(xb2);
    }
    run_phase<PH>();
    run_from<PH + 1>(grid);
  }
}

__global__ void __launch_bounds__(NTHREADS) mega(Params pk) {
  cg::grid_group grid = cg::this_grid();
  unsigned* bar = (unsigned*)(get_pp()->ws + OFF_BAR);
  volatile XLAS unsigned* st = (volatile XLAS unsigned*)((XLAS unsigned char*)g_smem + LDS_ST_OFF);
  if (threadIdx.x == 0) { st[0] = 0u; st[1] = 0u; st[2] = 0u; st[3] = 0u; }
  if (blockIdx.x == 0) {
    for (int i = threadIdx.x; i < 4096; i += NTHREADS) __hip_atomic_store(&bar[i], 0u, __ATOMIC_RELAXED, __HIP_MEMORY_SCOPE_AGENT);
    __threadfence();
  }
  __syncthreads();
  run_from<0>(grid);
}

extern "C" void kernel_launch(void* const* d_in, const int* in_sizes, int n_in, void* d_out, int out_size,
                              void* d_ws, size_t ws_size, hipStream_t stream) {
  static int grid_blocks = 0;
  if (!grid_blocks) {
    int dev = 0, cus = 0, per_cu = 0;
    hipGetDevice(&dev);
    hipFuncSetAttribute((const void*)mega, hipFuncAttributeMaxDynamicSharedMemorySize, SHM_BYTES);
    hipDeviceGetAttribute(&cus, hipDeviceAttributeMultiprocessorCount, dev);
    hipOccupancyMaxActiveBlocksPerMultiprocessor(&per_cu, mega, NTHREADS, SHM_BYTES);
    if (per_cu > 1) per_cu = 1;
    grid_blocks = cus * per_cu;
  }
  if (ws_size < WS_NEEDED) fprintf(stderr, "workspace too small: %zu < %zu\n", ws_size, (size_t)WS_NEEDED);
  Params p{};
  const float** pf = (const float**)&p;
  for (int i = 0; i < 28; ++i) pf[i] = (const float*)d_in[i];
  p.out = (float*)d_out;
  p.ws = (char*)d_ws;
  p.phase_lo = 0;
  p.phase_hi = N_PHASES;
  p.rep_phase = -1;
  void* args[] = {&p};
  hipError_t e = hipLaunchCooperativeKernel((void*)mega, dim3(grid_blocks), dim3(NTHREADS), args, SHM_BYTES, stream);
  if (e != hipSuccess) fprintf(stderr, "cooperative launch failed: %s (grid %d)\n", hipGetErrorString(e), grid_blocks);
}
```
